# Optimizing an MI355X kernel written in HIP

```python
import math, functools
import jax, jax.numpy as jnp
from jax import lax
import numpy as np

D_MODEL = 1024
BATCH = 4
SEQ = 4096
DEPTH = 1
DEC_BATCH = 128
DEC_SEQ = 8
PAST_LEN = 8192
PAGE_SIZE = 128

SSM_WIDTH = D_MODEL // 2
SSM_GROUP = 16
SSM_GROUPS = SSM_WIDTH // SSM_GROUP
SSM_STATE = 64
DT_MIN = 0.001
DT_MAX = 0.1
N_HEADS = 8
Q_LORA = 384
KV_LORA = 256
QK_NOPE = 64
QK_ROPE = 32
QK_HEAD = QK_NOPE + QK_ROPE
V_HEAD = 64
ROPE_THETA = 10000.0
ATTN_SCALE = QK_HEAD ** -0.5
Q_BLOCK = 128
D_FF = ((8 * D_MODEL // 3 + 255) // 256) * 256
PLE_DIM = 256
EPS = 1e-6
SPLIT_POINTS = (SSM_WIDTH,
                SSM_WIDTH + Q_LORA,
                SSM_WIDTH + Q_LORA + KV_LORA,
                SSM_WIDTH + Q_LORA + KV_LORA + QK_ROPE,
                SSM_WIDTH + Q_LORA + KV_LORA + QK_ROPE + D_MODEL)
D_IN = SPLIT_POINTS[-1] + D_MODEL

kernel_name = 'hybrid_s5_mla_decoder_step'


def rms_norm(x, g):
    xf = x.astype(jnp.float32)
    y = xf * lax.rsqrt(jnp.mean(xf * xf, axis=-1, keepdims=True) + EPS)
    return (y * g.astype(jnp.float32)).astype(x.dtype)


def qk_norm(x_nope, x_rope, g_nope, g_rope_half):
    nf = x_nope.astype(jnp.float32)
    rf = x_rope.astype(jnp.float32)
    ms = (jnp.sum(nf * nf, -1, keepdims=True) + jnp.sum(rf * rf, -1, keepdims=True)) / QK_HEAD
    r = lax.rsqrt(ms + EPS)
    g_rope = jnp.concatenate([g_rope_half, g_rope_half]).astype(jnp.float32)
    return ((nf * r * g_nope.astype(jnp.float32)).astype(x_nope.dtype),
            (rf * r * g_rope).astype(x_rope.dtype))


def rope_tables(pos):
    half = QK_ROPE // 2
    inv = ROPE_THETA ** (-jnp.arange(half, dtype=jnp.float32) / half)
    ang = pos.astype(jnp.float32)[:, None] * inv[None, :]
    return jnp.cos(ang), jnp.sin(ang)


def apply_rope(x, cos, sin):
    half = QK_ROPE // 2
    xf = x.astype(jnp.float32)
    x1, x2 = xf[..., :half], xf[..., half:]
    return jnp.concatenate([x1 * cos - x2 * sin, x2 * cos + x1 * sin], -1).astype(x.dtype)


def ssm_discretize(lam_re, lam_im, log_dt, b_re, b_im):
    lr, li = lam_re.astype(jnp.float32), lam_im.astype(jnp.float32)
    dt = jnp.exp(log_dt.astype(jnp.float32))[:, None]
    mag = jnp.exp(lr * dt)
    lb_re, lb_im = mag * jnp.cos(li * dt), mag * jnp.sin(li * dt)
    num_re, num_im = lb_re - 1.0, lb_im
    den = lr * lr + li * li
    f_re = (num_re * lr + num_im * li) / den
    f_im = (num_im * lr - num_re * li) / den
    br, bi = b_re.astype(jnp.float32), b_im.astype(jnp.float32)
    bb_re = f_re[..., None] * br - f_im[..., None] * bi
    bb_im = f_re[..., None] * bi + f_im[..., None] * br
    return lb_re, lb_im, bb_re, bb_im


def _complex_affine_combine(e1, e2):
    a1r, a1i, b1r, b1i = e1
    a2r, a2i, b2r, b2i = e2
    return (a1r * a2r - a1i * a2i,
            a1r * a2i + a1i * a2r,
            a2r * b1r - a2i * b1i + b2r,
            a2r * b1i + a2i * b1r + b2i)


def ssm_scan(u, h0_re, h0_im, lb_re, lb_im, bb_re, bb_im, c_re, c_im, d):
    bsz, t = u.shape[:2]
    uf = u.astype(jnp.float32)
    ug = uf.reshape(bsz, t, SSM_GROUPS, SSM_GROUP)
    bu_re = jnp.einsum('btgc,gnc->btgn', ug, bb_re)
    bu_im = jnp.einsum('btgc,gnc->btgn', ug, bb_im)
    h0r, h0i = h0_re.astype(jnp.float32), h0_im.astype(jnp.float32)
    bu_re = bu_re.at[:, 0].add(lb_re * h0r - lb_im * h0i)
    bu_im = bu_im.at[:, 0].add(lb_re * h0i + lb_im * h0r)
    a_re = jnp.broadcast_to(lb_re, bu_re.shape)
    a_im = jnp.broadcast_to(lb_im, bu_im.shape)
    _, _, h_re, h_im = lax.associative_scan(_complex_affine_combine, (a_re, a_im, bu_re, bu_im), axis=1)
    y = (jnp.einsum('btgn,gcn->btgc', h_re, c_re.astype(jnp.float32))
         - jnp.einsum('btgn,gcn->btgc', h_im, c_im.astype(jnp.float32)))
    y = y.reshape(bsz, t, SSM_WIDTH) + d.astype(jnp.float32) * uf
    return y.astype(u.dtype), h_re[:, -1], h_im[:, -1]


def mla_keys_values(ckv, kpe, lw):
    k_nope = jnp.einsum('...tc,chd->...thd', ckv, lw['w_uk'])
    v = jnp.einsum('...tc,chd->...thd', ckv, lw['w_uv'])
    k_rope = jnp.broadcast_to(kpe[..., None, :], k_nope.shape[:-1] + (QK_ROPE,))
    k_nope, k_rope = qk_norm(k_nope, k_rope, lw['k_norm_nope_g'], lw['k_norm_rope_g'])
    return jnp.concatenate([k_nope, k_rope], -1), v


def prompt_attend(q, ckv, kpe, lw):
    k, v = mla_keys_values(ckv, kpe, lw)
    bsz, t = q.shape[:2]
    kpos = jnp.arange(t)

    def block(i):
        qb = lax.dynamic_slice_in_dim(q, i * Q_BLOCK, Q_BLOCK, axis=1)
        s = jnp.einsum('bqhd,bkhd->bhqk', qb, k).astype(jnp.float32) * ATTN_SCALE
        qpos = i * Q_BLOCK + jnp.arange(Q_BLOCK)
        s = jnp.where(kpos[None, :] <= qpos[:, None], s, -jnp.inf)
        pr = jax.nn.softmax(s, axis=-1).astype(v.dtype)
        return jnp.einsum('bhqk,bkhd->bqhd', pr, v)

    out = lax.map(block, jnp.arange(t // Q_BLOCK))
    return out.transpose(1, 0, 2, 3, 4).reshape(bsz, t, N_HEADS, V_HEAD)


def sample_attend(q, ckv, kpe, lw, cache_ckv_l, cache_kpe_l, page_table):
    past = page_table.shape[1] * PAGE_SIZE
    tq = q.shape[1]
    kidx = jnp.arange(past + tq)
    qidx = past + jnp.arange(tq)
    mask = kidx[None, :] <= qidx[:, None]

    def one(args):
        q_b, ckv_b, kpe_b, pt = args
        ckv_all = jnp.concatenate([cache_ckv_l[pt].reshape(-1, KV_LORA), ckv_b.astype(cache_ckv_l.dtype)], 0)
        kpe_all = jnp.concatenate([cache_kpe_l[pt].reshape(-1, QK_ROPE), kpe_b.astype(cache_kpe_l.dtype)], 0)
        k, v = mla_keys_values(ckv_all, kpe_all, lw)
        s = jnp.einsum('qhd,khd->hqk', q_b, k).astype(jnp.float32) * ATTN_SCALE
        s = jnp.where(mask[None], s, -jnp.inf)
        pr = jax.nn.softmax(s, axis=-1).astype(v.dtype)
        return jnp.einsum('hqk,khd->qhd', pr, v)

    return lax.map(one, (q, ckv, kpe, page_table))


def decoder_layer(x, p, cos, sin, h0_re, h0_im, attend, lw):
    bsz, t = x.shape[:2]
    h = rms_norm(x, lw['norm_attn_g'])
    proj = h @ lw['w_in']
    u, q_lat, kv_lat, k_rope, g_a, g_b = jnp.split(proj, SPLIT_POINTS, axis=-1)
    lb_re, lb_im, bb_re, bb_im = ssm_discretize(lw['ssm_lam_re'], lw['ssm_lam_im'], lw['ssm_log_dt'],
                                                lw['ssm_b_re'], lw['ssm_b_im'])
    y_ssm, hT_re, hT_im = ssm_scan(u, h0_re, h0_im, lb_re, lb_im, bb_re, bb_im,
                                   lw['ssm_c_re'], lw['ssm_c_im'], lw['ssm_d'])
    z = jax.nn.gelu(y_ssm)
    a_out = z * jax.nn.sigmoid(z @ lw['w_glu'])
    qc = rms_norm(q_lat, lw['q_norm_g'])
    q = jnp.einsum('btc,chd->bthd', qc, lw['w_uq'])
    q_nope = q[..., :QK_NOPE]
    q_rope = apply_rope(q[..., QK_NOPE:], cos[:, None, :], sin[:, None, :])
    q_nope, q_rope = qk_norm(q_nope, q_rope, lw['q_norm_nope_g'], lw['q_norm_rope_g'])
    q = jnp.concatenate([q_nope, q_rope], -1)
    ckv = rms_norm(kv_lat, lw['kv_norm_g'])
    kpe = apply_rope(k_rope, cos, sin)
    b_out = attend(q, ckv, kpe).reshape(bsz, t, N_HEADS * V_HEAD)
    merged = (jax.nn.sigmoid(g_a) * (a_out @ lw['w_branch_a'])
              + jax.nn.sigmoid(g_b) * (b_out @ lw['w_branch_b']))
    x = x + merged @ lw['w_out']
    hf = rms_norm(x, lw['norm_ffn_g'])
    x = x + (jax.nn.silu(hf @ lw['w_gate']) * (hf @ lw['w_up'])) @ lw['w_down']
    gate = jax.nn.sigmoid(rms_norm(x, lw['norm_ple_g']) @ lw['w_ple_gate'])
    x = x + gate * (p @ lw['w_ple'])
    return x, ckv, kpe, hT_re, hT_im


def setup_inputs(seed: int = 0) -> dict:
    key = jax.random.key(seed)
    keys = jax.random.split(key, 64)
    ks = iter([keys[i] for i in range(64)])

    def nrm(shape, scale):
        return jax.random.normal(next(ks), shape, jnp.float32) * scale

    def gain(shape):
        return 1.0 + 0.01 * jax.random.normal(next(ks), shape, jnp.float32)

    n_pages = PAST_LEN // PAGE_SIZE
    n_used = DEC_BATCH * n_pages
    n_pool = n_used + n_used // 4
    L = DEPTH
    inp = {}
    inp['x_prompt'] = nrm((BATCH, SEQ, D_MODEL), 1.0)
    inp['x_sample'] = nrm((DEC_BATCH, DEC_SEQ, D_MODEL), 1.0)
    inp['p_prompt'] = nrm((L, BATCH, SEQ, PLE_DIM), 1.0)
    inp['p_sample'] = nrm((L, DEC_BATCH, DEC_SEQ, PLE_DIM), 1.0)
    inp['cache_ckv'] = nrm((L, n_pool, PAGE_SIZE, KV_LORA), 1.0)
    inp['cache_kpe'] = nrm((L, n_pool, PAGE_SIZE, QK_ROPE), 1.0)
    inp['state_ssm_re'] = nrm((L, DEC_BATCH, SSM_GROUPS, SSM_STATE), 0.3)
    inp['state_ssm_im'] = nrm((L, DEC_BATCH, SSM_GROUPS, SSM_STATE), 0.3)
    inp['page_table'] = jax.random.permutation(next(ks), n_pool)[:n_used].reshape(DEC_BATCH, n_pages).astype(jnp.int32)
    inp['norm_attn_g'] = gain((L, D_MODEL))
    inp['w_in'] = nrm((L, D_MODEL, D_IN), D_MODEL ** -0.5)
    inp['q_norm_g'] = gain((L, Q_LORA))
    inp['w_uq'] = nrm((L, Q_LORA, N_HEADS, QK_HEAD), Q_LORA ** -0.5)
    inp['kv_norm_g'] = gain((L, KV_LORA))
    inp['w_uk'] = nrm((L, KV_LORA, N_HEADS, QK_NOPE), KV_LORA ** -0.5)
    inp['w_uv'] = nrm((L, KV_LORA, N_HEADS, V_HEAD), KV_LORA ** -0.5)
    inp['q_norm_nope_g'] = gain((L, QK_NOPE))
    inp['q_norm_rope_g'] = gain((L, QK_ROPE // 2))
    inp['k_norm_nope_g'] = gain((L, QK_NOPE))
    inp['k_norm_rope_g'] = gain((L, QK_ROPE // 2))
    inp['ssm_lam_re'] = -0.5 + nrm((L, SSM_GROUPS, SSM_STATE), 0.01)
    inp['ssm_lam_im'] = (math.pi * jnp.arange(SSM_STATE, dtype=jnp.float32))[None, None, :] + nrm((L, SSM_GROUPS, SSM_STATE), 0.01)
    inp['ssm_log_dt'] = jax.random.uniform(next(ks), (L, SSM_GROUPS), jnp.float32, math.log(DT_MIN), math.log(DT_MAX))
    inp['ssm_b_re'] = nrm((L, SSM_GROUPS, SSM_STATE, SSM_GROUP), (2 * SSM_GROUP) ** -0.5)
    inp['ssm_b_im'] = nrm((L, SSM_GROUPS, SSM_STATE, SSM_GROUP), (2 * SSM_GROUP) ** -0.5)
    inp['ssm_c_re'] = nrm((L, SSM_GROUPS, SSM_GROUP, SSM_STATE), SSM_STATE ** -0.5)
    inp['ssm_c_im'] = nrm((L, SSM_GROUPS, SSM_GROUP, SSM_STATE), SSM_STATE ** -0.5)
    inp['ssm_d'] = nrm((L, SSM_WIDTH), 1.0)
    inp['w_glu'] = nrm((L, SSM_WIDTH, SSM_WIDTH), SSM_WIDTH ** -0.5)
    inp['w_branch_a'] = nrm((L, SSM_WIDTH, D_MODEL), SSM_WIDTH ** -0.5)
    inp['w_branch_b'] = nrm((L, N_HEADS * V_HEAD, D_MODEL), (N_HEADS * V_HEAD) ** -0.5)
    inp['w_out'] = nrm((L, D_MODEL, D_MODEL), D_MODEL ** -0.5)
    inp['norm_ffn_g'] = gain((L, D_MODEL))
    inp['w_gate'] = nrm((L, D_MODEL, D_FF), D_MODEL ** -0.5)
    inp['w_up'] = nrm((L, D_MODEL, D_FF), D_MODEL ** -0.5)
    inp['w_down'] = nrm((L, D_FF, D_MODEL), D_FF ** -0.5)
    inp['norm_ple_g'] = gain((L, D_MODEL))
    inp['w_ple_gate'] = nrm((L, D_MODEL, D_MODEL), D_MODEL ** -0.5)
    inp['w_ple'] = nrm((L, PLE_DIM, D_MODEL), PLE_DIM ** -0.5)
    return inp


def reference(x_prompt, x_sample, p_prompt, p_sample, cache_ckv, cache_kpe, state_ssm_re, state_ssm_im,
              page_table, norm_attn_g, w_in, q_norm_g, w_uq, kv_norm_g, w_uk, w_uv, q_norm_nope_g,
              q_norm_rope_g, k_norm_nope_g, k_norm_rope_g, ssm_lam_re, ssm_lam_im, ssm_log_dt, ssm_b_re,
              ssm_b_im, ssm_c_re, ssm_c_im, ssm_d, w_glu, w_branch_a, w_branch_b, w_out, norm_ffn_g,
              w_gate, w_up, w_down, norm_ple_g, w_ple_gate, w_ple):
    cos_p, sin_p = rope_tables(jnp.arange(x_prompt.shape[1]))
    cos_s, sin_s = rope_tables(PAST_LEN + jnp.arange(x_sample.shape[1]))
    h0_prompt = jnp.zeros((x_prompt.shape[0], SSM_GROUPS, SSM_STATE), jnp.float32)
    xp, xs = x_prompt, x_sample
    ckv_p, kpe_p, hre_p, him_p = [], [], [], []
    ckv_s, kpe_s, hre_s, him_s = [], [], [], []
    for i in range(DEPTH):
        lw = dict(norm_attn_g=norm_attn_g[i], w_in=w_in[i], q_norm_g=q_norm_g[i], w_uq=w_uq[i],
                  kv_norm_g=kv_norm_g[i], w_uk=w_uk[i], w_uv=w_uv[i], q_norm_nope_g=q_norm_nope_g[i],
                  q_norm_rope_g=q_norm_rope_g[i], k_norm_nope_g=k_norm_nope_g[i],
                  k_norm_rope_g=k_norm_rope_g[i], ssm_lam_re=ssm_lam_re[i], ssm_lam_im=ssm_lam_im[i],
                  ssm_log_dt=ssm_log_dt[i], ssm_b_re=ssm_b_re[i], ssm_b_im=ssm_b_im[i],
                  ssm_c_re=ssm_c_re[i], ssm_c_im=ssm_c_im[i], ssm_d=ssm_d[i], w_glu=w_glu[i],
                  w_branch_a=w_branch_a[i], w_branch_b=w_branch_b[i], w_out=w_out[i],
                  norm_ffn_g=norm_ffn_g[i], w_gate=w_gate[i], w_up=w_up[i], w_down=w_down[i],
                  norm_ple_g=norm_ple_g[i], w_ple_gate=w_ple_gate[i], w_ple=w_ple[i])
        attend_p = functools.partial(prompt_attend, lw=lw)
        attend_s = functools.partial(sample_attend, lw=lw, cache_ckv_l=cache_ckv[i],
                                     cache_kpe_l=cache_kpe[i], page_table=page_table)
        xp, c1, k1, r1, m1 = decoder_layer(xp, p_prompt[i], cos_p, sin_p, h0_prompt, h0_prompt, attend_p, lw)
        xs, c2, k2, r2, m2 = decoder_layer(xs, p_sample[i], cos_s, sin_s, state_ssm_re[i], state_ssm_im[i], attend_s, lw)
        ckv_p.append(c1); kpe_p.append(k1); hre_p.append(r1); him_p.append(m1)
        ckv_s.append(c2); kpe_s.append(k2); hre_s.append(r2); him_s.append(m2)
    return (xp, xs,
            jnp.stack(ckv_p), jnp.stack(kpe_p), jnp.stack(hre_p), jnp.stack(him_p),
            jnp.stack(ckv_s), jnp.stack(kpe_s), jnp.stack(hre_s), jnp.stack(him_s))
```

```cpp
#include <hip/hip_runtime.h>
#include <cstdio>
#include <cstdint>
#ifndef REP_SSM3
#define REP_SSM3 1
#endif
#ifndef REP_PATTN
#define REP_PATTN 1
#endif
#ifndef REP_SATTN
#define REP_SATTN 1
#endif
#ifndef REP_P0
#define REP_P0 1
#endif
#ifndef REP_NORM
#define REP_NORM 1
#endif
#ifndef REP_CONV
#define REP_CONV 1
#endif
#ifndef REP_SC
#define REP_SC 1
#endif
#ifndef REP_FIN
#define REP_FIN 1
#endif
#ifndef REP_PV
#define REP_PV 1
#endif
#ifndef REP_BAR
#define REP_BAR 0
#endif
#ifndef TWIN_FAR
#define TWIN_FAR 0
#endif
#ifndef REP_SETUP
#define REP_SETUP 1
#endif
#ifndef REP_EPI
#define REP_EPI 1
#endif
#ifndef REP_LOAD
#define REP_LOAD 1
#endif
#ifndef REP_P2
#define REP_P2 1
#endif
#ifndef REP_P4
#define REP_P4 1
#endif
#ifndef REP_P5
#define REP_P5 1
#endif
#ifndef REP_P7
#define REP_P7 1
#endif
#ifndef REP_P9
#define REP_P9 1
#endif
#ifndef REP_E1
#define REP_E1 1
#endif
#ifndef REP_SSM1
#define REP_SSM1 1
#endif
#ifndef REP_P1
#define REP_P1 1
#endif
#ifndef REP_P6
#define REP_P6 1
#endif
#ifndef XTRA_BAR
#define XTRA_BAR 0
#endif
#ifndef S_ORDER
#define S_ORDER 0
#endif
#if S_ORDER == 0
#define S_BLK_ORDER(t, PF, PFK) do { S_BLK_NORMS(t); S_BLK_SCORES(t); S_BLK_PV(t); S_BLK_CONV(t, PF, PFK); } while (0)
#elif S_ORDER == 1
#define S_BLK_ORDER(t, PF, PFK) do { S_BLK_CONV(t, PF, PFK); S_BLK_PV(t); S_BLK_SCORES(t); S_BLK_NORMS(t); } while (0)
#elif S_ORDER == 2
#define S_BLK_ORDER(t, PF, PFK) do { S_BLK_CONV(t, PF, PFK); S_BLK_NORMS(t); S_BLK_SCORES(t); S_BLK_PV(t); } while (0)
#else
#define S_BLK_ORDER(t, PF, PFK) do { S_BLK_PV(t); S_BLK_NORMS(t); S_BLK_SCORES(t); S_BLK_CONV(t, PF, PFK); } while (0)
#endif
#ifndef PROF_K
#define PROF_K -1
#endif
#ifndef PROF_TID
#define PROF_TID 0
#endif
#ifndef S_DUAL
#define S_DUAL 1
#endif
#ifndef S_VAR
#define S_VAR 7
#endif
#if S_VAR == 0
#define S_ORDER_BODY(t, PF, PFK) do { if (wid < 4) { S_BLK_NORMS(t); S_BLK_SCORES(t); } S_BLK_PV(t); S_BLK_CONV(t, PF, PFK); if (wid >= 4) { S_BLK_SCORES(t); S_BLK_NORMS(t); } } while (0)
#elif S_VAR == 1
#define S_ORDER_BODY(t, PF, PFK) do { if (wid < 4) { S_BLK_NORMS(t); S_BLK_SCORES(t); } S_BLK_CONV(t, PF, PFK); S_BLK_PV(t); if (wid >= 4) { S_BLK_SCORES(t); S_BLK_NORMS(t); } } while (0)
#elif S_VAR == 2
#define S_ORDER_BODY(t, PF, PFK) do { if (wid < 4) { S_BLK_SCORES(t); S_BLK_NORMS(t); } S_BLK_PV(t); S_BLK_CONV(t, PF, PFK); if (wid >= 4) { S_BLK_NORMS(t); S_BLK_SCORES(t); } } while (0)
#elif S_VAR == 3
#define S_ORDER_BODY(t, PF, PFK) do { if (wid < 4) { S_BLK_NORMS(t); } S_BLK_SCORES(t); S_BLK_PV(t); S_BLK_CONV(t, PF, PFK); if (wid >= 4) { S_BLK_NORMS(t); } } while (0)
#elif S_VAR == 4
#define S_ORDER_BODY(t, PF, PFK) do { if (wid < 4) { S_BLK_NORMS(t); } S_BLK_PV(t); S_BLK_CONV(t, PF, PFK); S_BLK_SCORES(t); if (wid >= 4) { S_BLK_NORMS(t); } } while (0)
#elif S_VAR == 5
#define S_ORDER_BODY(t, PF, PFK) do { if (wid < 4) { S_BLK_SCORES(t); S_BLK_NORMS(t); } S_BLK_CONV(t, PF, PFK); S_BLK_PV(t); if (wid >= 4) { S_BLK_NORMS(t); S_BLK_SCORES(t); } } while (0)
#elif S_VAR == 6
#define S_ORDER_BODY(t, PF, PFK) do { if (wid < 4) { S_BLK_SCORES(t); S_BLK_NORMS(t); } S_BLK_PV(t); S_BLK_CONV(t, PF, PFK); if (wid >= 4) { S_BLK_SCORES(t); S_BLK_NORMS(t); } } while (0)
#elif S_VAR == 7
#define S_ORDER_BODY(t, PF, PFK) do { if (wid < 4) { S_BLK_NORMS(t); S_BLK_SCORES(t); } S_BLK_PV(t); S_BLK_CONV(t, PF, PFK); if (wid >= 4) { S_BLK_NORMS(t); S_BLK_SCORES(t); } } while (0)
#elif S_VAR == 8
#define S_ORDER_BODY(t, PF, PFK) do { if (wid >= 4) { S_BLK_SCORES(t); S_BLK_NORMS(t); } S_BLK_PV(t); S_BLK_CONV(t, PF, PFK); if (wid < 4) { S_BLK_NORMS(t); S_BLK_SCORES(t); } } while (0)
#else
#define S_ORDER_BODY(t, PF, PFK) do { if ((wid & 1) == 0) { S_BLK_SCORES(t); S_BLK_NORMS(t); } S_BLK_PV(t); S_BLK_CONV(t, PF, PFK); if ((wid & 1) != 0) { S_BLK_NORMS(t); S_BLK_SCORES(t); } } while (0)
#endif
namespace pg8 {
#define PG8_LAS __attribute__((address_space(3)))
typedef unsigned short bf16_t;
typedef short bf16x8 __attribute__((ext_vector_type(8)));
typedef float f32x4 __attribute__((ext_vector_type(4)));
typedef unsigned u32x4 __attribute__((ext_vector_type(4)));
constexpr int BM = 256, BK = 64, HALF = 128, HTB = HALF * BK * 2  , STAGE_BYTES = 8 * HTB, NXCD = 8, WGM = 8;

__host__ __device__ __forceinline__ int lds_byte(int r, int c) { const int st = (r >> 4) * 2 + (c >> 5), rr = r & 15, cc = c & 31, ob = rr * 64 + cc * 2; return st * 1024 + (ob ^ (((ob >> 9) & 1) << 5)); }
__host__ __device__ __forceinline__ void stage_rc(int b, int& R, int& C) { const int st = b / 1024, sb = b % 1024, swz = sb ^ (((sb >> 9) & 1) << 5); R = (st >> 1) * 16 + swz / 64; C = (st & 1) * 32 + (swz % 64) / 2; }
__host__ __device__ __forceinline__ int perm32(int rho) { const int n = rho >> 4, i = rho & 15; return 8 * (i >> 2) + 4 * n + (i & 3); }

struct Unit { int pm, pn, ko, id; };
struct Gemm { const bf16_t* A; const bf16_t* Bt; int M, N, K, lda, ldb; };

struct SplitKOrder {
    int pm0, ntile, nslice, klen, G, c, id0;
    __host__ __device__ bool next(int i, Unit& u) const { if (c < 0) return false; const int L = i * G + c; if (L >= ntile * nslice) return false; const int sl = L % nslice, t = L / nslice;
        u.pm = pm0 + (t >> 2); u.pn = t & 3; u.ko = sl * klen; u.id = id0 + L; return true; }
    __device__ __forceinline__ void a_ready(const Unit&) const {}
    __device__ __forceinline__ void done(const Unit&) const {}
};
struct StaticOrder {
    int nM, nN, nwg, G, c;
    __host__ __device__ void init(int M, int N, int G_, int c_) { nM = M / BM; nN = N / BM; nwg = nM * nN; G = G_; c = c_; }
    __host__ __device__ bool next(int i, Unit& u) const {
        const long L = (long)i * G + c; if (L >= nwg) return false;
        int wgid = (int)L; { const int q = nwg / NXCD, r = nwg % NXCD, xcd = wgid % NXCD, off = wgid / NXCD; wgid = (xcd < r ? xcd * (q + 1) : r * (q + 1) + (xcd - r) * q) + off; }
        const int nig = WGM * nN, gid = wgid / nig, fm = gid * WGM, gsz = (nM - fm) < WGM ? (nM - fm) : WGM;
        u.pm = fm + ((wgid % nig) % gsz); u.pn = (wgid % nig) / gsz; u.ko = 0; u.id = 0; return true;
    }
    __device__ __forceinline__ void a_ready(const Unit&) const {}
    __device__ __forceinline__ void done(const Unit&) const {}
};
struct PromptPlusTail {
    StaticOrder S; int w0, bx, pm0;
    __host__ __device__ bool next(int i, Unit& u) const { if (i == 0) return S.next(0, u); if (i == 1 && bx >= w0 && bx < w0 + 16) { const int t = bx - w0; u.pm = pm0 + (t >> 2); u.pn = t & 3; u.ko = 0; u.id = 0; return true; } return false; }
    __device__ __forceinline__ void a_ready(const Unit&) const {}
    __device__ __forceinline__ void done(const Unit&) const {}
};
__device__ __forceinline__ unsigned cvt_pk_bf16(float lo, float hi) { unsigned r; asm volatile("v_cvt_pk_bf16_f32 %0, %1, %2" : "=v"(r) : "v"(lo), "v"(hi)); return r; }
template <class Epi, class Sched, bool ALIGN_EPI = false, bool SP2 = false>
__device__ __forceinline__ void gemm_phase(PG8_LAS unsigned char* lds, const Gemm g, const Sched& S, const Epi& E) {
    int tid_ = threadIdx.x; asm volatile("" : "+v"(tid_));
    const int tid = tid_, wid = __builtin_amdgcn_readfirstlane(tid >> 6), lane = tid & 63, wr = wid >> 2, wc = wid & 3, fr = lane & 15, fq = lane >> 4;
    const int K = g.K, nt = K / BK;
    unsigned voffA[2], voffB[2];
#pragma unroll
    for (int i = 0; i < 2; ++i) { int R, C; stage_rc(tid * 16 + i * 8192, R, C); const int Rb = Epi::PERM ? ((R & ~31) + perm32(R & 31)) : R;
        voffA[i] = (unsigned)(R * g.lda + C) * 2u; voffB[i] = (unsigned)(Rb * g.ldb + C) * 2u; }
    const size_t kstep = (size_t)(BK * 2);
    const size_t hstepA = (size_t)HALF * g.lda * 2, hstepB = (size_t)HALF * g.ldb * 2;
    const size_t tstepA = 2 * hstepA, tstepB = 2 * hstepB;
    const unsigned ldsw = (unsigned)wid * 1024u;
    const int aoff = lds_byte(wr * 64 + fr, fq * 8), boff = lds_byte(wc * 32 + fr, fq * 8);
#define PG8_SA(b, h) (((b) * 2 + (h)) * HTB)
#define PG8_SB(b, h) ((4 + (b) * 2 + (h)) * HTB)
#define PG8_STAGE(bufoff, gbase, voff) do { _Pragma("unroll") for (int _i = 0; _i < 2; ++_i) \
        __builtin_amdgcn_global_load_lds((const unsigned*)((const char*)(gbase) + (voff)[_i]), (PG8_LAS unsigned*)(lds + (bufoff) + ldsw + _i * 8192), 16, 0, 0); } while (0)
#define PG8_LDA(dst, b, h) do { _Pragma("unroll") for (int m = 0; m < 4; ++m) _Pragma("unroll") for (int k = 0; k < 2; ++k) dst[m][k] = *(const PG8_LAS bf16x8*)(lds + PG8_SA(b, h) + aoff + m * 2048 + k * 1024); } while (0)
#define PG8_LDB(dst, b, h) do { _Pragma("unroll") for (int n = 0; n < 2; ++n) _Pragma("unroll") for (int k = 0; k < 2; ++k) dst[n][k] = *(const PG8_LAS bf16x8*)(lds + PG8_SB(b, h) + boff + n * 2048 + k * 1024); } while (0)
#define PG8_MMA(ai, bj, At, Bt) do { __builtin_amdgcn_s_setprio(1); _Pragma("unroll") for (int m = 0; m < 4; ++m) _Pragma("unroll") for (int n = 0; n < 2; ++n) _Pragma("unroll") for (int k = 0; k < 2; ++k) \
        acc[ai][bj][m][n] = __builtin_amdgcn_mfma_f32_16x16x32_bf16(Bt[n][k], At[m][k], acc[ai][bj][m][n], 0, 0, 0); __builtin_amdgcn_s_setprio(0); } while (0)
#define PG8_WAIT_V(n) asm volatile("s_waitcnt vmcnt(" #n ")" ::: "memory")
#define PG8_WAIT_L(n) asm volatile("s_waitcnt lgkmcnt(" #n ")" ::: "memory")
#define PG8_BAR __builtin_amdgcn_s_barrier()
#define PG8_SCHED __builtin_amdgcn_sched_barrier(0)
    Unit cur, nxt; int ui = 0;
    if (!S.next(0, cur)) return;
    f32x4 acc[2][2][4][2];
#pragma unroll
    for (int a = 0; a < 2; ++a)
#pragma unroll
        for (int b = 0; b < 2; ++b)
#pragma unroll
            for (int m = 0; m < 4; ++m)
#pragma unroll
                for (int n = 0; n < 2; ++n) acc[a][b][m][n] = (f32x4){0.f, 0.f, 0.f, 0.f};
    bf16x8 At[4][2], B0[2][2], B1[2][2];
    const char* cA = (const char*)g.A + (size_t)cur.pm * tstepA + (size_t)cur.ko * 2; const char* cB = (const char*)g.Bt + (size_t)cur.pn * tstepB + (size_t)cur.ko * 2;
    S.a_ready(cur);
    if constexpr (SP2) {
        PG8_STAGE(PG8_SB(0, 0), cB, voffB); PG8_STAGE(PG8_SB(0, 1), cB + hstepB, voffB); PG8_STAGE(PG8_SA(0, 0), cA, voffA); PG8_STAGE(PG8_SA(0, 1), cA + hstepA, voffA);
        if (wr == 1) PG8_BAR;
        PG8_WAIT_V(2); PG8_BAR;
        PG8_STAGE(PG8_SB(1, 0), cB + kstep, voffB); PG8_STAGE(PG8_SA(1, 0), cA + kstep, voffA); PG8_STAGE(PG8_SB(1, 1), cB + hstepB + kstep, voffB);
        PG8_WAIT_V(6); PG8_BAR;
    } else {
        PG8_STAGE(PG8_SB(0, 0), cB, voffB); PG8_STAGE(PG8_SA(0, 0), cA, voffA); PG8_STAGE(PG8_SB(0, 1), cB + hstepB, voffB); PG8_STAGE(PG8_SA(0, 1), cA + hstepA, voffA);
        if (wr == 1) PG8_BAR;
        PG8_WAIT_V(4); PG8_BAR;
        PG8_STAGE(PG8_SB(1, 0), cB + kstep, voffB); PG8_STAGE(PG8_SA(1, 0), cA + kstep, voffA); PG8_STAGE(PG8_SB(1, 1), cB + hstepB + kstep, voffB);
        PG8_WAIT_V(6); PG8_BAR;
    }
    for (;;) {
        const bool has_next = S.next(ui + 1, nxt);
        const char* nA = has_next ? (const char*)g.A + (size_t)nxt.pm * tstepA + (size_t)nxt.ko * 2 : cA; const char* nB = has_next ? (const char*)g.Bt + (size_t)nxt.pn * tstepB + (size_t)nxt.ko * 2 : cB;
#pragma unroll 1
        for (int t = 0; t < nt; t += 2) {
            const bool last = (t == nt - 2);
            const char* a1 = cA + (size_t)(t + 1) * kstep;
            const char* a2 = last ? nA : cA + (size_t)(t + 2) * kstep; const char* b2 = last ? nB : cB + (size_t)(t + 2) * kstep;
            const char* a3 = a2 + kstep; const char* b3 = b2 + kstep;
            if (last && has_next) S.a_ready(nxt);
            if constexpr (SP2) {
            PG8_LDB(B0, 0, 0); PG8_LDB(B1, 0, 1); PG8_SCHED; PG8_LDA(At, 0, 0); PG8_STAGE(PG8_SA(1, 1), a1 + hstepA, voffA);
            PG8_WAIT_V(8); PG8_WAIT_L(0); PG8_BAR; PG8_MMA(0, 0, At, B0); PG8_MMA(0, 1, At, B1); PG8_BAR; PG8_SCHED;
            PG8_LDA(At, 0, 1); PG8_STAGE(PG8_SB(0, 0), b2, voffB); PG8_STAGE(PG8_SB(0, 1), b2 + hstepB, voffB); PG8_STAGE(PG8_SA(0, 0), a2, voffA);
            PG8_WAIT_V(8); PG8_WAIT_L(0); PG8_BAR; PG8_MMA(1, 0, At, B0); PG8_MMA(1, 1, At, B1); PG8_BAR; PG8_SCHED;
            PG8_LDB(B0, 1, 0); PG8_LDB(B1, 1, 1); PG8_SCHED; PG8_LDA(At, 1, 0); PG8_STAGE(PG8_SA(0, 1), a2 + hstepA, voffA);
            PG8_WAIT_V(8); PG8_WAIT_L(0); PG8_BAR; PG8_MMA(0, 0, At, B0); PG8_MMA(0, 1, At, B1); PG8_BAR; PG8_SCHED;
            PG8_LDA(At, 1, 1); PG8_STAGE(PG8_SB(1, 0), b3, voffB); PG8_STAGE(PG8_SB(1, 1), b3 + hstepB, voffB); PG8_STAGE(PG8_SA(1, 0), a3, voffA);
            PG8_WAIT_V(8); PG8_WAIT_L(0); PG8_BAR; PG8_MMA(1, 0, At, B0); PG8_MMA(1, 1, At, B1); PG8_BAR; PG8_SCHED;
            } else {
            PG8_LDB(B0, 0, 0); PG8_SCHED; PG8_LDA(At, 0, 0); PG8_STAGE(PG8_SA(1, 1), a1 + hstepA, voffA);
            PG8_WAIT_L(8); PG8_BAR; PG8_WAIT_L(0); PG8_MMA(0, 0, At, B0); PG8_BAR; PG8_SCHED;
            PG8_LDB(B1, 0, 1); PG8_STAGE(PG8_SB(0, 0), b2, voffB);
            PG8_BAR; PG8_WAIT_L(0); PG8_MMA(0, 1, At, B1); PG8_BAR;
            PG8_LDA(At, 0, 1); PG8_STAGE(PG8_SA(0, 0), a2, voffA);
            PG8_BAR; PG8_WAIT_L(0); PG8_MMA(1, 0, At, B0); PG8_BAR; PG8_SCHED;
            PG8_STAGE(PG8_SB(0, 1), b2 + hstepB, voffB);
            PG8_WAIT_V(6); PG8_BAR; PG8_MMA(1, 1, At, B1); PG8_BAR;
            PG8_LDB(B0, 1, 0); PG8_SCHED; PG8_LDA(At, 1, 0); PG8_STAGE(PG8_SA(0, 1), a2 + hstepA, voffA);
            PG8_WAIT_L(8); PG8_BAR; PG8_WAIT_L(0); PG8_MMA(0, 0, At, B0); PG8_BAR; PG8_SCHED;
            PG8_LDB(B1, 1, 1); PG8_STAGE(PG8_SB(1, 0), b3, voffB);
            PG8_BAR; PG8_WAIT_L(0); PG8_MMA(0, 1, At, B1); PG8_BAR;
            PG8_LDA(At, 1, 1); PG8_STAGE(PG8_SA(1, 0), a3, voffA);
            PG8_BAR; PG8_WAIT_L(0); PG8_MMA(1, 0, At, B0); PG8_BAR; PG8_SCHED;
            PG8_STAGE(PG8_SB(1, 1), b3 + hstepB, voffB);
            PG8_WAIT_V(6); PG8_BAR; PG8_MMA(1, 1, At, B1); PG8_BAR;
            }
        }
        if constexpr (ALIGN_EPI) { if (wr == 0) PG8_BAR; }
        if constexpr (!Epi::AFTER_DRAIN) { E(acc, cur, wr, wc, fr, fq); S.done(cur); }
        if (!has_next) break;
#pragma unroll
        for (int a = 0; a < 2; ++a)
#pragma unroll
            for (int b = 0; b < 2; ++b)
#pragma unroll
                for (int m = 0; m < 4; ++m)
#pragma unroll
                    for (int n = 0; n < 2; ++n) acc[a][b][m][n] = (f32x4){0.f, 0.f, 0.f, 0.f};
        cur = nxt; cA = nA; cB = nB; ++ui;
        if constexpr (ALIGN_EPI) { if (wr == 1) PG8_BAR; }
    }
    PG8_WAIT_V(0);
    if constexpr (!ALIGN_EPI) { if (wr == 0) PG8_BAR; }
    PG8_BAR;
    if constexpr (Epi::AFTER_DRAIN) { E.fused(acc, cur, wr, wc, fr, fq, lds, wid, lane); S.done(cur); }
#undef PG8_SA
#undef PG8_SB
#undef PG8_STAGE
#undef PG8_LDA
#undef PG8_LDB
#undef PG8_MMA
#undef PG8_WAIT_V
#undef PG8_WAIT_L
#undef PG8_BAR
#undef PG8_SCHED
}
}
#define GAS __attribute__((address_space(1)))
#define LAS __attribute__((address_space(3)))
typedef unsigned short bf16;
typedef unsigned v4u __attribute__((ext_vector_type(4)));
typedef unsigned v2u __attribute__((ext_vector_type(2)));
typedef float f32x4 __attribute__((ext_vector_type(4)));
typedef float f32x2 __attribute__((ext_vector_type(2)));
typedef float f32x16 __attribute__((ext_vector_type(16)));
typedef short bf16x8 __attribute__((ext_vector_type(8)));
typedef short s16x4 __attribute__((ext_vector_type(4)));
typedef GAS unsigned gu32;
#define RLX_AGENT __ATOMIC_RELAXED, __HIP_MEMORY_SCOPE_AGENT
#define LDS_WAIT() asm volatile("s_waitcnt lgkmcnt(0)" ::: "memory")
#define VM_WAIT() asm volatile("s_waitcnt vmcnt(0)" ::: "memory")
__device__ __forceinline__ unsigned f2bf(float f) { unsigned u = __builtin_bit_cast(unsigned, f); return (u + 0x7fffu + ((u >> 16) & 1u)) >> 16; }
__device__ __forceinline__ unsigned pk2(float lo, float hi) { return f2bf(lo) | (f2bf(hi) << 16); }
__device__ __forceinline__ float bflo(unsigned w) { return __builtin_bit_cast(float, w << 16); }
__device__ __forceinline__ float bfhi(unsigned w) { return __builtin_bit_cast(float, w & 0xffff0000u); }
__device__ __forceinline__ float bf1(bf16 b) { return __builtin_bit_cast(float, (unsigned)b << 16); }
__device__ __forceinline__ float rsq(float x) { return __builtin_amdgcn_rsqf(x); }
__device__ __forceinline__ float sigmf(float x) { return __builtin_amdgcn_rcpf(1.f + __builtin_amdgcn_exp2f(-1.4426950408889634f * x)); }

__device__ __forceinline__ void xhalf_both(float v, float& lo, float& hi) { lo = v; hi = v; asm volatile("s_nop 1\n\tv_permlane32_swap_b32 %0, %1" : "+v"(lo), "+v"(hi)); }
__device__ __forceinline__ float xrow16_sum(float v) { float a = v, b = v; asm volatile("s_nop 1\n\tv_permlane16_swap_b32 %0, %1" : "+v"(a), "+v"(b)); return a + b; }
__device__ __forceinline__ float xhalf_sum(float v) { float a, b; xhalf_both(v, a, b); return a + b; }
__device__ __forceinline__ float sum8_dpp(float v) {
    v += __builtin_bit_cast(float, __builtin_amdgcn_update_dpp(0, __builtin_bit_cast(int, v), 0xB1, 0xF, 0xF, true));
    v += __builtin_bit_cast(float, __builtin_amdgcn_update_dpp(0, __builtin_bit_cast(int, v), 0x4E, 0xF, 0xF, true));
    v += __builtin_bit_cast(float, __builtin_amdgcn_update_dpp(0, __builtin_bit_cast(int, v), 0x141, 0xF, 0xF, true));
    return v; }
namespace mk {
constexpr int NWAVES = 8;
constexpr int M = 17408, MP = 16384, MS = 1024, D = 1024, SEQ = 4096, DSEQ = 8, PAST = 8192;
constexpr int NPROJ = 3328, PC_U = 0, PC_Q = 512, PC_KR = 896, PC_KV = 1024, PC_GA = 1280, PC_GB = 2304;
constexpr int DFF = 2816, NGU = 5632;
constexpr float EPS = 1e-6f;
constexpr size_t O_Y = 0, O_CKV_P = 17825792, O_KPE_P = 22020096, O_HRE_P = 22544384, O_HIM_P = 22552576, O_CKV_S = 22560768, O_KPE_S = 22822912, O_HRE_S = 22855680, O_HIM_S = 23117824;

constexpr size_t al(size_t x) { return (x + 4095) & ~(size_t)4095; }
constexpr size_t WS_CTL = 0, CTL_ZERO_BYTES = 1u << 20;
constexpr int CW_TMO = 0, CW_CODE = 1, CW_BAR = 4096;
constexpr size_t CTL_SSQ_Q = 256 * 1024, CTL_SSQ_KV = 384 * 1024, CTL_SSQ_X1 = 512 * 1024, CTL_SSQ_X2 = 640 * 1024, CTL_CMP = 768 * 1024;
constexpr size_t WS_WIN = CTL_ZERO_BYTES;
constexpr size_t WS_WUQ = WS_WIN + al((size_t)NPROJ * 1024 * 2);
constexpr size_t WS_WUKV = WS_WUQ + al((size_t)768 * 384 * 2);
constexpr size_t WS_WGLU = WS_WUKV + al((size_t)1024 * 256 * 2);
constexpr size_t WS_WA = WS_WGLU + al((size_t)512 * 512 * 2);
constexpr size_t WS_WB = WS_WA + al((size_t)1024 * 512 * 2);
constexpr size_t WS_WOUT = WS_WB + al((size_t)1024 * 512 * 2);
constexpr size_t WS_WGU = WS_WOUT + al((size_t)1024 * 1024 * 2);
constexpr size_t WS_WDN = WS_WGU + al((size_t)NGU * 1024 * 2);
constexpr size_t WS_WPG = WS_WDN + al((size_t)1024 * DFF * 2);
constexpr size_t WS_WPLE = WS_WPG + al((size_t)1024 * 1024 * 2);
constexpr size_t WS_CS = WS_WPLE + al((size_t)1024 * 256 * 2);
constexpr size_t WS_SSMD = WS_CS + al((size_t)4104 * 32 * 4);
constexpr size_t WS_RX = WS_SSMD + al((size_t)(2 * 2048 + 2 * 2048 * 16 + 2 * 2048) * 4);
constexpr size_t WS_XB = WS_RX + al((size_t)M * 4);
constexpr size_t WS_PB = WS_XB + al((size_t)M * 1024 * 2);
constexpr size_t WS_PROJ = WS_PB + al((size_t)M * 256 * 2);
constexpr size_t WS_QB = WS_PROJ + al((size_t)M * NPROJ * 2);
constexpr size_t WS_KB = WS_QB + al((size_t)M * 768 * 2);
constexpr size_t WS_VB = WS_KB + al((size_t)M * 768 * 2);
constexpr size_t WS_ZB = WS_VB + al((size_t)M * 512 * 2);
constexpr size_t WS_AOUT = WS_ZB + al((size_t)M * 512 * 2);
constexpr size_t WS_BOUT = WS_AOUT + al((size_t)M * 512 * 2);
constexpr size_t WS_TMP = WS_BOUT + al((size_t)M * 512 * 2);
constexpr size_t WS_MRG = WS_TMP + al((size_t)M * 1024 * 2);
constexpr size_t WS_XR = WS_MRG + al((size_t)M * 1024 * 2);
constexpr size_t WS_X1B = WS_XR + al((size_t)M * 1024 * 4);
constexpr size_t WS_ACT = WS_X1B + al((size_t)M * 1024 * 2);
constexpr size_t WS_PW = WS_ACT + al((size_t)M * DFF * 2);
constexpr size_t WS_SST = WS_PW + al((size_t)M * 1024 * 2);
constexpr size_t WS_SPART = WS_SST + al((size_t)4 * 32 * 64 * 128 * 4);
constexpr size_t WS_CKVS = WS_SPART + al((size_t)64 << 20);
constexpr size_t WS_KPES = WS_CKVS + al((size_t)1024 * 256 * 2);
constexpr size_t WS_GT = WS_KPES + al((size_t)1024 * 32 * 2);
constexpr size_t WS_WUKS = WS_GT + 4096;
constexpr size_t WS_END = WS_WUKS + al((size_t)512 * 256 * 2);

constexpr int RING_BYTES = 131072, LDS_BYTES = 163840, LDSCTL_OFF = LDS_BYTES - 512, MISC_OFF = LDSCTL_OFF + 320;

#define XB_TMO      128
#define XB_XCNT(j)  (256  + 64 * (j))
#define XB_XSUB(j)  (1280 + 64 * (j))
#define XB_XGEN(j)  (2304 + 64 * (j))
#define XB_TOP      3328
#define XB_TOPGEN   3392
#define XCD_BAR_WORDS 3456
#define XB_SPIN_CAP (1u << 18)
__device__ __forceinline__ unsigned xb_ld(unsigned* p)              { return __hip_atomic_load(p, __ATOMIC_RELAXED, __HIP_MEMORY_SCOPE_AGENT); }
__device__ __forceinline__ unsigned xb_add(unsigned* p, unsigned v) { return __hip_atomic_fetch_add(p, v, __ATOMIC_RELAXED, __HIP_MEMORY_SCOPE_AGENT); }
__device__ __forceinline__ unsigned xb_xcc_id() { return (unsigned)__builtin_amdgcn_s_getreg((3 << 11) | 20) & 0xFu; }
#define XB_SPIN(cond, bar) do { unsigned _sp = 0; while (cond) { __builtin_amdgcn_s_sleep(1); \
    if ((++_sp & 255u) == 0u) { if (xb_ld(&(bar)[XB_TMO])) break; if (_sp > XB_SPIN_CAP) { atomicAdd(&(bar)[XB_TMO], 1u); break; } } } } while (0)
struct XcdBarrier { unsigned* bar; unsigned x; volatile LAS unsigned* st; };
__device__ __forceinline__ XcdBarrier xcd_barrier_post(unsigned* bar, volatile LAS unsigned* st) {
    XcdBarrier b; b.bar = bar; b.x = xb_xcc_id(); b.st = st;
    if (threadIdx.x == 0) (void)xb_add(&bar[XB_XCNT(b.x)], 1u);
    return b;
}
__device__ __forceinline__ void xcd_barrier_complete(unsigned* bar, unsigned x, unsigned& nloc, unsigned& nx) {
    const unsigned G = gridDim.x * gridDim.y * gridDim.z;
    unsigned sum, cnt, mine, sp = 0u;
    for (;;) {
        sum = 0u; cnt = 0u; mine = 0u;
#pragma unroll
        for (unsigned j = 0; j < 16; ++j) { const unsigned c = xb_ld(&bar[XB_XCNT(j)]); sum += c; cnt += (c > 0u) ? 1u : 0u; mine = (j == x) ? c : mine; }
        if (sum == G) break;
        __builtin_amdgcn_s_sleep(1);
        if ((++sp & 255u) == 0u) { if (xb_ld(&bar[XB_TMO])) break; if (sp > XB_SPIN_CAP) { atomicAdd(&bar[XB_TMO], 1u); break; } }
    }
    nloc = mine > 0u ? mine : 1u; nx = cnt > 0u ? cnt : 1u;
}
__device__ __forceinline__ void xcd_barrier(const XcdBarrier& b) {
    asm volatile("s_waitcnt vmcnt(0)" ::: "memory");
    __syncthreads();
    if (threadIdx.x == 0) {
        unsigned* bar = b.bar;
        __builtin_amdgcn_s_waitcnt(0);
        unsigned nloc = b.st[0], nx = b.st[1];
        if (nloc == 0u) { xcd_barrier_complete(bar, b.x, nloc, nx); b.st[0] = nloc; b.st[1] = nx; }
        const unsigned old = xb_add(&bar[XB_XSUB(b.x)], 1u);
        const unsigned gen = old / nloc;
        if (old + 1u == (gen + 1u) * nloc) {
            __builtin_amdgcn_fence(__ATOMIC_RELEASE, "agent");
            asm volatile("s_waitcnt vmcnt(0)" ::: "memory");
            const unsigned og = xb_add(&bar[XB_TOP], 1u);
            const unsigned tg = og / nx;
            if (og + 1u == (tg + 1u) * nx) xb_add(&bar[XB_TOPGEN], 1u);
            else XB_SPIN(xb_ld(&bar[XB_TOPGEN]) == tg, bar);
            __builtin_amdgcn_fence(__ATOMIC_ACQUIRE, "agent");
            xb_add(&bar[XB_XGEN(b.x)], 1u);
            asm volatile("s_waitcnt vmcnt(0)" ::: "memory");
        } else {
            XB_SPIN(xb_ld(&bar[XB_XGEN(b.x)]) == gen, bar);
            __builtin_amdgcn_fence(__ATOMIC_ACQUIRE, "agent");
            asm volatile("s_waitcnt vmcnt(0)" ::: "memory");
        }
    }
    __syncthreads();
}

struct Args { const float* in[39]; float* out; unsigned char* ws; int ph_lo, ph_hi; };

__device__ __forceinline__ float wave_sum(float v) {
#pragma unroll
    for (int o = 1; o < 64; o <<= 1) v += __shfl_xor(v, o);
    return v;
}
__device__ __forceinline__ float wave_sum_fast(float v) {
    v = sum8_dpp(v);
    v += __builtin_bit_cast(float, __builtin_amdgcn_update_dpp(0, __builtin_bit_cast(int, v), 0x140, 0xF, 0xF, true));
    const float r0 = __builtin_bit_cast(float, __builtin_amdgcn_readlane(__builtin_bit_cast(int, v), 0)), r1 = __builtin_bit_cast(float, __builtin_amdgcn_readlane(__builtin_bit_cast(int, v), 16));
    const float r2 = __builtin_bit_cast(float, __builtin_amdgcn_readlane(__builtin_bit_cast(int, v), 32)), r3 = __builtin_bit_cast(float, __builtin_amdgcn_readlane(__builtin_bit_cast(int, v), 48));
    return (r0 + r1) + (r2 + r3);
}
__device__ __forceinline__ const float* xrow_ptr(const Args& a, int m) { return m < MP ? a.in[0] + (size_t)m * D : a.in[1] + (size_t)(m - MP) * D; }
__device__ __forceinline__ int pos_idx(int m) { return m < MP ? (m & (SEQ - 1)) : SEQ + ((m - MP) & (DSEQ - 1)); }

struct MatInfo { int K, Np; size_t off; };
__device__ __forceinline__ MatInfo mat_info(int id) {
    switch (id) {
        case 0: return {1024, NPROJ, WS_WIN}; case 1: return {384, 768, WS_WUQ}; case 2: return {256, 1024, WS_WUKV}; case 3: return {512, 512, WS_WGLU};
        case 4: return {512, 1024, WS_WA}; case 5: return {512, 1024, WS_WB}; case 6: return {1024, 1024, WS_WOUT}; case 7: return {1024, NGU, WS_WGU};
        case 8: return {DFF, 1024, WS_WDN}; case 9: return {1024, 1024, WS_WPG}; case 10: return {256, 1024, WS_WPLE}; default: return {256, 512, WS_WUKS};
    }
}
constexpr int mat_items(int K, int Np) { return (K / 64) * (Np / 32); }
__device__ __forceinline__ void mat_src(const Args& a, int id, int n0, const float*& W, int& ld, const float*& gain) {
    gain = nullptr;
    switch (id) {
        case 0: { gain = a.in[9]; ld = 3232; int c;
            if (n0 < 896) c = n0; else if (n0 < 928) c = 1152 + (n0 - 896); else if (n0 < 1024) c = -1; else if (n0 < 1280) c = 896 + (n0 - 1024); else if (n0 < 2304) c = 1184 + (n0 - 1280); else c = 2208 + (n0 - 2304);
            W = c < 0 ? nullptr : a.in[10] + c; return; }
        case 1: gain = a.in[11]; ld = 768; W = a.in[12] + n0; return;
        case 2: { gain = a.in[13]; ld = 512;
            if (n0 < 512) { const int pn = n0 >> 8, ct = n0 & 255, bj = ct >> 7, wc = (ct & 127) >> 5; W = a.in[14] + (4 * pn + wc) * 64 + 32 * bj; }
            else W = a.in[15] + (n0 - 512); return; }
        case 3: ld = 512; W = a.in[28] + n0; return;
        case 4: ld = 1024; W = a.in[29] + n0; return;
        case 5: ld = 1024; W = a.in[30] + n0; return;
        case 6: ld = 1024; W = a.in[31] + n0; return;
        case 7: { gain = a.in[32]; ld = DFF; const int pn = n0 >> 8, ct = n0 & 255; W = ((ct >> 7) ? a.in[34] : a.in[33]) + 128 * pn + (ct & 127); return; }
        case 8: ld = 1024; W = a.in[35] + n0; return;
        case 9: gain = a.in[36]; ld = 1024; W = a.in[37] + n0; return;
        case 10: ld = 1024; W = a.in[38] + n0; return;
        default: ld = 512; W = a.in[14] + n0; return;
    }
}
__device__ __forceinline__ void p0_transpose_item(const Args& a, int id, int item, bf16* WT, int K, int Np, LAS float* scr, int lane) {
    const int nblk = Np / 32, kb = item / nblk, nb = item % nblk, k0 = 64 * kb, n0 = 32 * nb;
    const float* W; int ld; const float* gain; mat_src(a, id, n0, W, ld, gain);
    { const int kr = lane >> 3, c4 = 4 * (lane & 7);
#pragma unroll
      for (int i = 0; i < 8; ++i) { const int kk = 8 * i + kr; f32x4 v = {0.f, 0.f, 0.f, 0.f};
          if (W) { v = *(const GAS f32x4*)(W + (size_t)(k0 + kk) * ld + c4); if (gain) v *= gain[k0 + kk]; }
          scr[kk * 33 + c4] = v[0]; scr[kk * 33 + c4 + 1] = v[1]; scr[kk * 33 + c4 + 2] = v[2]; scr[kk * 33 + c4 + 3] = v[3]; } }
    LDS_WAIT(); asm volatile("" ::: "memory");
    const int c = lane & 7;
#pragma unroll
    for (int j = 0; j < 4; ++j) { const int n = (lane >> 3) + 8 * j; const LAS float* s = scr + (8 * c) * 33 + n;
        v4u o; o.x = pk2(s[0 * 33], s[1 * 33]); o.y = pk2(s[2 * 33], s[3 * 33]); o.z = pk2(s[4 * 33], s[5 * 33]); o.w = pk2(s[6 * 33], s[7 * 33]);
        *(GAS v4u*)(WT + (size_t)(n0 + n) * K + k0 + 8 * c) = o; }
    LDS_WAIT(); asm volatile("" ::: "memory");
}
template <int SEL>
__device__ __forceinline__ void p0_weights(const Args& a, LAS unsigned char* lds, int gw, int NGW, int wave, int lane) {
    unsigned char* ws = a.ws;
    LAS float* scr = (LAS float*)(lds + wave * 16384);
    int base = 0;
#pragma unroll 1
    for (int id = 0; id < 12; ++id) { if (((0x3C0 >> id) & 1) != SEL) continue;
        const MatInfo mi = mat_info(id); const int n = (mi.K / 64) * (mi.Np / 32);
        for (int it = (gw + NGW - (base % NGW)) % NGW; it < n; it += NGW) p0_transpose_item(a, id, it, (bf16*)(ws + mi.off), mi.K, mi.Np, scr, lane);
        base += n; }
}
__device__ __forceinline__ void p0_prologue(const Args& a, LAS unsigned char* lds, int vcu, int G, int wave, int lane) {
    unsigned char* ws = a.ws;
    LAS float* scr = (LAS float*)(lds + wave * 16384);
    const int gw = vcu * NWAVES + wave, NGW = G * NWAVES;
    p0_weights<0>(a, lds, gw, NGW, wave, lane);
    float* rx = (float*)(ws + WS_RX); bf16* xb = (bf16*)(ws + WS_XB); bf16* pb = (bf16*)(ws + WS_PB);
    for (int m0 = gw; m0 < M; m0 += 2 * NGW) { const int m1 = m0 + NGW; const bool two = m1 < M;
        const GAS f32x4* xr0 = (const GAS f32x4*)xrow_ptr(a, m0) + lane; const GAS f32x4* xr1 = (const GAS f32x4*)xrow_ptr(a, two ? m1 : m0) + lane;
        f32x4 v0[4], v1[4];
#pragma unroll
        for (int j = 0; j < 4; ++j) { v0[j] = xr0[64 * j]; v1[j] = xr1[64 * j]; }
        const float* pr0 = m0 < MP ? a.in[2] + (size_t)m0 * 256 : a.in[3] + (size_t)(m0 - MP) * 256; const int mm1 = two ? m1 : m0;
        const float* pr1 = mm1 < MP ? a.in[2] + (size_t)mm1 * 256 : a.in[3] + (size_t)(mm1 - MP) * 256;
        const f32x4 pv0 = ((const GAS f32x4*)pr0)[lane], pv1 = ((const GAS f32x4*)pr1)[lane];
        float s0 = 0.f, s1 = 0.f;
#pragma unroll
        for (int j = 0; j < 4; ++j) { s0 += (v0[j].x * v0[j].x + v0[j].y * v0[j].y) + (v0[j].z * v0[j].z + v0[j].w * v0[j].w); s1 += (v1[j].x * v1[j].x + v1[j].y * v1[j].y) + (v1[j].z * v1[j].z + v1[j].w * v1[j].w); }
        s0 = wave_sum_fast(s0); s1 = wave_sum_fast(s1);
        if (lane == 0) { rx[m0] = 1.f / sqrtf(s0 * (1.f / D) + EPS); if (two) rx[m1] = 1.f / sqrtf(s1 * (1.f / D) + EPS); }
        GAS v2u* o0 = (GAS v2u*)(xb + (size_t)m0 * D) + lane; GAS v2u* o1 = (GAS v2u*)(xb + (size_t)mm1 * D) + lane;
#pragma unroll
        for (int j = 0; j < 4; ++j) { v2u w; w.x = pk2(v0[j].x, v0[j].y); w.y = pk2(v0[j].z, v0[j].w); o0[64 * j] = w; }
        if (two) {
#pragma unroll
            for (int j = 0; j < 4; ++j) { v2u w; w.x = pk2(v1[j].x, v1[j].y); w.y = pk2(v1[j].z, v1[j].w); o1[64 * j] = w; } }
        { v2u w; w.x = pk2(pv0.x, pv0.y); w.y = pk2(pv0.z, pv0.w); ((GAS v2u*)(pb + (size_t)m0 * 256))[lane] = w; }
        if (two) { v2u w; w.x = pk2(pv1.x, pv1.y); w.y = pk2(pv1.z, pv1.w); ((GAS v2u*)(pb + (size_t)m1 * 256))[lane] = w; }
    }
    float* cs = (float*)(ws + WS_CS);
    for (int e = gw * 64 + lane; e < 4104 * 16; e += NGW * 64) { const int idx = e >> 4, i = e & 15; const int pos = idx < SEQ ? idx : PAST + (idx - SEQ);
        constexpr double INV[16] = {1.0, 0.5623413251903491, 0.31622776601683794, 0.1778279410038923, 0.1, 0.05623413251903491, 0.03162277660168379, 0.01778279410038923, 0.01,
                                    0.005623413251903491, 0.0031622776601683794, 0.0017782794100389228, 0.001, 0.0005623413251903491, 0.00031622776601683794, 0.00017782794100389227};
        const double ang = (double)pos * INV[i], k = rint(ang * 0.15915494309189535);
        double r = fma(-k, 6.283185307179586, ang); r = fma(-k, 2.4492935982947064e-16, r);
        cs[idx * 32 + i] = cosf((float)r); cs[idx * 32 + 16 + i] = sinf((float)r); }
    if (gw == 0) { float* gt = (float*)(ws + WS_GT); const float gn = a.in[18][lane] * a.in[16][lane]; gt[lane] = gn; float gm = fabsf(gn);
        if (lane < 16) { const float gr = a.in[19][lane] * a.in[17][lane]; gt[64 + lane] = gr; gm = fmaxf(gm, fabsf(gr)); }
#pragma unroll
        for (int o = 1; o < 64; o <<= 1) gm = fmaxf(gm, __shfl_xor(gm, o));
        if (lane == 0) gt[80] = 14.1352f * gm * 1.01f + 0.1f; }
    float* sd = (float*)(ws + WS_SSMD);
    for (int idx = gw * 64 + lane; idx < 2048; idx += NGW * 64) { const int g = idx >> 6;
        const float lr = a.in[20][idx], li = a.in[21][idx], dt = expf(a.in[22][g]);
        const float mag = expf(lr * dt), br_ = mag * cosf(li * dt), bi_ = mag * sinf(li * dt);
        sd[idx] = br_; sd[2048 + idx] = bi_;
        const float nr = br_ - 1.f, ni = bi_, den = lr * lr + li * li, fr = (nr * lr + ni * li) / den, fi = (ni * lr - nr * li) / den;
        for (int c = 0; c < 16; ++c) { const float b_r = a.in[23][idx * 16 + c], b_i = a.in[24][idx * 16 + c];
            sd[4096 + idx * 16 + c] = fr * b_r - fi * b_i; sd[4096 + 32768 + idx * 16 + c] = fr * b_i + fi * b_r; }
        float pr = br_, pi = bi_;
        for (int k = 0; k < 6; ++k) { const float t = pr * pr - pi * pi; pi = 2.f * pr * pi; pr = t; }
        sd[4096 + 65536 + idx] = pr; sd[4096 + 65536 + 2048 + idx] = pi; }
}

typedef const f32x4 (&AccT)[2][2][4][2];
__device__ __forceinline__ v4u pack8(const f32x4 v0, const f32x4 v1) { v4u w; w.x = pg8::cvt_pk_bf16(v0[0], v0[1]); w.y = pg8::cvt_pk_bf16(v0[2], v0[3]); w.z = pg8::cvt_pk_bf16(v1[0], v1[1]); w.w = pg8::cvt_pk_bf16(v1[2], v1[3]); return w; }
__device__ __forceinline__ float sq8(const v4u w) { float s = 0.f;
    s += bflo(w.x) * bflo(w.x) + bfhi(w.x) * bfhi(w.x); s += bflo(w.y) * bflo(w.y) + bfhi(w.y) * bfhi(w.y);
    s += bflo(w.z) * bflo(w.z) + bfhi(w.z) * bfhi(w.z); s += bflo(w.w) * bflo(w.w) + bfhi(w.w) * bfhi(w.w); return s; }
__device__ __forceinline__ float quad_sum(float s) { return xhalf_sum(xrow16_sum(s)); }

struct EpiG1 {
    static constexpr bool PERM = true, AFTER_DRAIN = false;
    bf16* O; const float* rx; float* ssq_q; float* ssq_kv;
    __device__ __forceinline__ void operator()(AccT acc, const pg8::Unit& u, int wr, int wc, int fr, int fq) const {
        const int row0 = u.pm * 256 + wr * 64 + fr, col0 = u.pn * 256 + wc * 32 + 8 * fq;
        const int mode = (u.pn == 2) ? 1 : (u.pn == 3) ? 2 : (u.pn == 4) ? 3 : 0;
#pragma unroll
        for (int ai = 0; ai < 2; ++ai)
#pragma unroll
            for (int m = 0; m < 4; ++m) { const int row = row0 + ai * 128 + m * 16; const float sc = rx[row]; bf16* rowp = O + (size_t)row * NPROJ + col0; float ss = 0.f;
#pragma unroll
                for (int bj = 0; bj < 2; ++bj) { const v4u w = pack8(acc[ai][bj][m][0] * sc, acc[ai][bj][m][1] * sc); *(v4u*)(rowp + bj * 128) = w;
                    if (mode == 1 || mode == 3 || (mode == 2 && bj == 0)) ss += sq8(w); }
                if (mode) { ss = quad_sum(ss); if (fq == 0) atomicAdd((mode == 3 ? ssq_kv : ssq_q) + row, ss); } }
    }
};
struct EpiRowScale {
    static constexpr bool PERM = true, AFTER_DRAIN = false;
    bf16* O; int ldc; const float* ssq; float inv_n;
    __device__ __forceinline__ void operator()(AccT acc, const pg8::Unit& u, int wr, int wc, int fr, int fq) const {
        const int row0 = u.pm * 256 + wr * 64 + fr, col0 = u.pn * 256 + wc * 32 + 8 * fq;
#pragma unroll
        for (int ai = 0; ai < 2; ++ai)
#pragma unroll
            for (int m = 0; m < 4; ++m) { const int row = row0 + ai * 128 + m * 16; const float sc = ssq ? rsq(ssq[row] * inv_n + EPS) : 1.f; bf16* rowp = O + (size_t)row * ldc + col0;
#pragma unroll
                for (int bj = 0; bj < 2; ++bj) *(v4u*)(rowp + bj * 128) = pack8(acc[ai][bj][m][0] * sc, acc[ai][bj][m][1] * sc); }
    }
};
}
namespace mk {
struct EpiKV {
    static constexpr bool PERM = true, AFTER_DRAIN = false;
    bf16* KB; bf16* VB; const float* ssq_kv; const bf16* projb; const float* cs; const float* gt;
    __device__ __forceinline__ void operator()(AccT acc, const pg8::Unit& u, int wr, int wc, int fr, int fq) const {
        const int row0 = u.pm * 256 + wr * 64 + fr;
        if (u.pn >= 2) {
            const int col0 = (u.pn - 2) * 256 + wc * 32 + 8 * fq;
#pragma unroll
            for (int ai = 0; ai < 2; ++ai)
#pragma unroll
                for (int m = 0; m < 4; ++m) { const int row = row0 + ai * 128 + m * 16; const float sc = rsq(ssq_kv[row] * (1.f / 256.f) + EPS); bf16* rowp = VB + (size_t)row * 512 + col0;
#pragma unroll
                    for (int bj = 0; bj < 2; ++bj) *(v4u*)(rowp + bj * 128) = pack8(acc[ai][bj][m][0] * sc, acc[ai][bj][m][1] * sc); }
            return;
        }
        const int head = 4 * u.pn + wc, ib = 8 * (fq & 1); const float sgn = fq < 2 ? -1.f : 1.f;
#pragma unroll
        for (int ai = 0; ai < 2; ++ai)
#pragma unroll
            for (int m = 0; m < 4; ++m) { const int row = row0 + ai * 128 + m * 16; const float sc = rsq(ssq_kv[row] * (1.f / 256.f) + EPS);
                float ss = 0.f;
#pragma unroll
                for (int bj = 0; bj < 2; ++bj)
#pragma unroll
                    for (int n = 0; n < 2; ++n) { const f32x4 x = acc[ai][bj][m][n]; ss += (x[0] * x[0] + x[1] * x[1]) + (x[2] * x[2] + x[3] * x[3]); }
                const bf16* krp = projb + (size_t)row * NPROJ + PC_KR;
                const v4u own = *(const v4u*)(krp + 8 * fq), par = *(const v4u*)(krp + 8 * (fq ^ 2));
                ss = quad_sum(ss * sc * sc + sq8(own));
                const float r = rsq(ss * (1.f / 96.f) + EPS), rs = r * sc;
                bf16* kp = KB + (size_t)row * 768 + head * 96;
#pragma unroll
                for (int bj = 0; bj < 2; ++bj) { const int d = 32 * bj + 8 * fq;
                    *(v4u*)(kp + d) = pack8(acc[ai][bj][m][0] * *(const f32x4*)(gt + d) * rs, acc[ai][bj][m][1] * *(const f32x4*)(gt + d + 4) * rs); }
                const float* csr = cs + (size_t)pos_idx(row) * 32 + ib;
                f32x4 o[2];
#pragma unroll
                for (int hh = 0; hh < 2; ++hh) { const unsigned ow0 = hh ? own.z : own.x, ow1 = hh ? own.w : own.y, pw0 = hh ? par.z : par.x, pw1 = hh ? par.w : par.y;
                    const f32x4 c = *(const f32x4*)(csr + 4 * hh), sn = *(const f32x4*)(csr + 16 + 4 * hh) * sgn, g = *(const f32x4*)(gt + 64 + ib + 4 * hh) * r;
                    const f32x4 xo = {bflo(ow0), bfhi(ow0), bflo(ow1), bfhi(ow1)}, xp = {bflo(pw0), bfhi(pw0), bflo(pw1), bfhi(pw1)};
                    o[hh] = (xo * c + xp * sn) * g; }
                *(v4u*)(kp + 64 + 8 * fq) = pack8(o[0], o[1]);
                asm volatile("" ::: "memory"); }
    }
};

__device__ __forceinline__ void e1_rows(const Args& a, int gw, int NGW, int lane) {
    unsigned char* ws = a.ws; const bf16* projb = (const bf16*)(ws + WS_PROJ); const float* ssq_kv = (const float*)(ws + CTL_SSQ_KV); const float* cs = (const float*)(ws + WS_CS);
    bf16* ckvs = (bf16*)(ws + WS_CKVS); bf16* kpes = (bf16*)(ws + WS_KPES); const float* gkv = a.in[13];
    const f32x4 g4 = *(const f32x4*)(gkv + 4 * lane);
    for (int m = gw; m < M; m += NGW) {
        const float sc = 1.f / sqrtf(ssq_kv[m] * (1.f / 256.f) + EPS);
        const v2u w = *(const GAS v2u*)(projb + (size_t)m * NPROJ + PC_KV + 4 * lane);
        f32x4 v = {bflo(w.x), bfhi(w.x), bflo(w.y), bfhi(w.y)}; v = v * sc * g4;
        float* oc = m < MP ? a.out + O_CKV_P + (size_t)m * 256 : a.out + O_CKV_S + (size_t)(m - MP) * 256;
        *(GAS f32x4*)(oc + 4 * lane) = v;
        if (m >= MP) { v2u o; o.x = pk2(v[0], v[1]); o.y = pk2(v[2], v[3]); *(GAS v2u*)(ckvs + (size_t)(m - MP) * 256 + 4 * lane) = o; }
        if (lane < 16) { const bf16* kr = projb + (size_t)m * NPROJ + PC_KR; const float x1 = bf1(kr[lane]), x2 = bf1(kr[16 + lane]);
            const float* csr = cs + (size_t)pos_idx(m) * 32; const float c = csr[lane], s = csr[16 + lane];
            const float o1 = x1 * c - x2 * s, o2 = x2 * c + x1 * s;
            float* ok = m < MP ? a.out + O_KPE_P + (size_t)m * 32 : a.out + O_KPE_S + (size_t)(m - MP) * 32;
            ok[lane] = o1; ok[16 + lane] = o2;
            if (m >= MP) { kpes[(size_t)(m - MP) * 32 + lane] = (bf16)f2bf(o1); kpes[(size_t)(m - MP) * 32 + 16 + lane] = (bf16)f2bf(o2); } }
    }
}
__device__ __forceinline__ void unpack8(const v4u w, f32x4& a, f32x4& b) { a = (f32x4){bflo(w.x), bfhi(w.x), bflo(w.y), bfhi(w.y)}; b = (f32x4){bflo(w.z), bfhi(w.z), bflo(w.w), bfhi(w.w)}; }
__device__ __forceinline__ f32x4 sig4(const f32x4 x) { return (f32x4){sigmf(x[0]), sigmf(x[1]), sigmf(x[2]), sigmf(x[3])}; }
template <int MODE> struct EpiGate {
    static constexpr bool PERM = true, AFTER_DRAIN = false;
    bf16* O; int ldc; const bf16* X; int ldx; int xoff; const bf16* T;
    __device__ __forceinline__ void operator()(AccT acc, const pg8::Unit& u, int wr, int wc, int fr, int fq) const {
        const int row0 = u.pm * 256 + wr * 64 + fr, col0 = u.pn * 256 + wc * 32 + 8 * fq;
#pragma unroll
        for (int ai = 0; ai < 2; ++ai)
#pragma unroll
            for (int m = 0; m < 4; ++m) { const int row = row0 + ai * 128 + m * 16;
#pragma unroll
                for (int bj = 0; bj < 2; ++bj) { const int col = col0 + bj * 128; f32x4 x0, x1; unpack8(*(const v4u*)(X + (size_t)row * ldx + xoff + col), x0, x1);
                    f32x4 o0, o1;
                    if (MODE == 0) { o0 = x0 * sig4(acc[ai][bj][m][0]); o1 = x1 * sig4(acc[ai][bj][m][1]); }
                    else { o0 = sig4(x0) * acc[ai][bj][m][0]; o1 = sig4(x1) * acc[ai][bj][m][1]; }
                    if (MODE == 2) { f32x4 t0, t1; unpack8(*(const v4u*)(T + (size_t)row * ldc + col), t0, t1); o0 += t0; o1 += t1; }
                    *(v4u*)(O + (size_t)row * ldc + col) = pack8(o0, o1); }
                asm volatile("" ::: "memory"); }
    }
};
template <bool BASE_X> struct EpiRes {
    static constexpr bool PERM = true, AFTER_DRAIN = false;
    bf16* XB; float* ssq; const float* xp; const float* xs;
    __device__ __forceinline__ void operator()(AccT acc, const pg8::Unit& u, int wr, int wc, int fr, int fq) const {
        const int row0 = u.pm * 256 + wr * 64 + fr, col0 = u.pn * 256 + wc * 32 + 8 * fq;
#pragma unroll
        for (int ai = 0; ai < 2; ++ai)
#pragma unroll
            for (int m = 0; m < 4; ++m) { const int row = row0 + ai * 128 + m * 16; float ss = 0.f;
#pragma unroll
                for (int bj = 0; bj < 2; ++bj) { const int col = col0 + bj * 128; f32x4 b0, b1;
                    if (BASE_X) { const float* bp = (row < MP ? xp + (size_t)row * 1024 : xs + (size_t)(row - MP) * 1024) + col; b0 = *(const f32x4*)bp; b1 = *(const f32x4*)(bp + 4); }
                    else unpack8(*(const v4u*)(XB + (size_t)row * 1024 + col), b0, b1);
                    const v4u w = pack8(b0 + acc[ai][bj][m][0], b1 + acc[ai][bj][m][1]); *(v4u*)(XB + (size_t)row * 1024 + col) = w; ss += sq8(w); }
                ss = quad_sum(ss); if (fq == 0) atomicAdd(ssq + row, ss);
                asm volatile("" ::: "memory"); }
    }
};
struct EpiSwiglu {
    static constexpr bool PERM = true, AFTER_DRAIN = false;
    bf16* O; const float* ssq;
    __device__ __forceinline__ void operator()(AccT acc, const pg8::Unit& u, int wr, int wc, int fr, int fq) const {
        const int row0 = u.pm * 256 + wr * 64 + fr, col0 = u.pn * 128 + wc * 32 + 8 * fq;
#pragma unroll
        for (int ai = 0; ai < 2; ++ai)
#pragma unroll
            for (int m = 0; m < 4; ++m) { const int row = row0 + ai * 128 + m * 16; const float r = rsq(ssq[row] * (1.f / 1024.f) + EPS);
                f32x4 o[2];
#pragma unroll
                for (int n = 0; n < 2; ++n) { const f32x4 g = acc[ai][0][m][n] * r, up = acc[ai][1][m][n] * r; o[n] = g * sig4(g) * up; }
                *(v4u*)(O + (size_t)row * DFF + col0) = pack8(o[0], o[1]); }
    }
};
struct EpiFinal {
    static constexpr bool PERM = true, AFTER_DRAIN = false;
    float* Y; const bf16* XB; const bf16* PW; const float* ssq;
    __device__ __forceinline__ void operator()(AccT acc, const pg8::Unit& u, int wr, int wc, int fr, int fq) const {
        const int row0 = u.pm * 256 + wr * 64 + fr, col0 = u.pn * 256 + wc * 32 + 8 * fq;
#pragma unroll
        for (int ai = 0; ai < 2; ++ai)
#pragma unroll
            for (int m = 0; m < 4; ++m) { const int row = row0 + ai * 128 + m * 16; const float r = rsq(ssq[row] * (1.f / 1024.f) + EPS);
#pragma unroll
                for (int bj = 0; bj < 2; ++bj) { const int col = col0 + bj * 128; f32x4 p0, p1, x0, x1; unpack8(*(const v4u*)(PW + (size_t)row * 1024 + col), p0, p1); unpack8(*(const v4u*)(XB + (size_t)row * 1024 + col), x0, x1);
                    *(f32x4*)(Y + (size_t)row * 1024 + col) = x0 + sig4(acc[ai][bj][m][0] * r) * p0;
                    *(f32x4*)(Y + (size_t)row * 1024 + col + 4) = x1 + sig4(acc[ai][bj][m][1] * r) * p1; }
                asm volatile("" ::: "memory"); }
    }
};
struct EpiSlab {
    static constexpr bool PERM = true, AFTER_DRAIN = false;
    float* slabs;
    __device__ __forceinline__ void operator()(AccT acc, const pg8::Unit& u, int wr, int wc, int fr, int fq) const {
        float* sb = slabs + (size_t)u.id * 65536; const int row0 = wr * 64 + fr, col0 = wc * 32 + 8 * fq;
#pragma unroll
        for (int ai = 0; ai < 2; ++ai)
#pragma unroll
            for (int m = 0; m < 4; ++m) { float* rp = sb + (row0 + ai * 128 + m * 16) * 256 + col0;
#pragma unroll
                for (int bj = 0; bj < 2; ++bj) { *(f32x4*)(rp + bj * 128) = acc[ai][bj][m][0]; *(f32x4*)(rp + bj * 128 + 4) = acc[ai][bj][m][1]; } }
    }
};
template <int NSLICE, int MODE>
__device__ __forceinline__ void combine_rows(const Args& a, int gw, int NGW, int lane) {
    unsigned char* ws = a.ws; bf16* XB = (bf16*)(ws + WS_X1B); const float* slabs = (const float*)(ws + WS_SPART);
    float* ssq = (float*)(ws + (MODE == 1 ? CTL_SSQ_X1 : CTL_SSQ_X2));
    for (int it = gw; it < MS * 4; it += NGW) { const int r = it >> 2, pn = it & 3, row = MP + r, t = (r >> 8) * 4 + pn, rr = r & 255; const size_t eo = (size_t)row * 1024 + pn * 256 + 4 * lane;
        const float* sp = slabs + (size_t)(t * NSLICE) * 65536 + rr * 256 + 4 * lane;
        f32x4 p[NSLICE];
#pragma unroll
        for (int sl = 0; sl < NSLICE; ++sl) p[sl] = *(const GAS f32x4*)(sp + (size_t)sl * 65536);
        f32x4 base;
        if (MODE == 1) base = *(const GAS f32x4*)(a.in[1] + (size_t)r * 1024 + pn * 256 + 4 * lane);
        else { const v2u bw = *(const GAS v2u*)(XB + eo); base = (f32x4){bflo(bw.x), bfhi(bw.x), bflo(bw.y), bfhi(bw.y)}; }
        f32x4 v = p[0];
#pragma unroll
        for (int sl = 1; sl < NSLICE; ++sl) v += p[sl];
        if (MODE == 2) { const float rs = rsq(ssq[row] * (1.f / 1024.f) + EPS); const v2u pw = *(const GAS v2u*)((const bf16*)(ws + WS_PW) + eo);
            const f32x4 pv = {bflo(pw.x), bfhi(pw.x), bflo(pw.y), bfhi(pw.y)};
            *(GAS f32x4*)(a.out + O_Y + eo) = base + sig4(v * rs) * pv; }
        else { v += base;
            v2u w; w.x = pg8::cvt_pk_bf16(v[0], v[1]); w.y = pg8::cvt_pk_bf16(v[2], v[3]); *(GAS v2u*)(XB + eo) = w;
            float ss = (bflo(w.x) * bflo(w.x) + bfhi(w.x) * bfhi(w.x)) + (bflo(w.y) * bflo(w.y) + bfhi(w.y) * bfhi(w.y));
            ss = wave_sum_fast(ss); if (lane == 0) atomicAdd(ssq + row, ss); } }
}
__device__ __forceinline__ void combine_merge(const Args& a, int gw, int NGW, int lane) {
    unsigned char* ws = a.ws; const float* slabs = (const float*)(ws + WS_SPART); const bf16* projb = (const bf16*)(ws + WS_PROJ); bf16* MR = (bf16*)(ws + WS_MRG);
    for (int it = gw; it < MS * 4; it += NGW) { const int r = it >> 2, pn = it & 3, row = MP + r, t = (r >> 8) * 4 + pn, rr = r & 255, col = pn * 256 + 4 * lane;
        const float* sa = slabs + (size_t)(2 * t) * 65536 + rr * 256 + 4 * lane; const float* sb = slabs + (size_t)(32 + 2 * t) * 65536 + rr * 256 + 4 * lane;
        const f32x4 a0 = *(const GAS f32x4*)sa, a1 = *(const GAS f32x4*)(sa + 65536), b0 = *(const GAS f32x4*)sb, b1 = *(const GAS f32x4*)(sb + 65536);
        const v2u ga = *(const GAS v2u*)(projb + (size_t)row * NPROJ + PC_GA + col), gb = *(const GAS v2u*)(projb + (size_t)row * NPROJ + PC_GB + col);
        const f32x4 fa = {bflo(ga.x), bfhi(ga.x), bflo(ga.y), bfhi(ga.y)}, fb = {bflo(gb.x), bfhi(gb.x), bflo(gb.y), bfhi(gb.y)};
        const f32x4 v = sig4(fa) * (a0 + a1) + sig4(fb) * (b0 + b1);
        v2u w; w.x = pg8::cvt_pk_bf16(v[0], v[1]); w.y = pg8::cvt_pk_bf16(v[2], v[3]); *(GAS v2u*)(MR + (size_t)row * 1024 + col) = w; }
}
}
namespace mk {
constexpr int SD_LBR = 0, SD_LBI = 2048, SD_BBR = 4096, SD_BBI = 4096 + 32768, SD_PR = 4096 + 65536, SD_PI = 4096 + 65536 + 2048;
__device__ __forceinline__ float gelu_tanh_f(float x) { const float a = 0.7978845608028654f * (x + 0.044715f * x * x * x); return x * sigmf(2.f * a); }

__device__ __forceinline__ void ssm_stage_u(const bf16* projb, int row0, int ntok, int g, LAS float* U, int lane) {
    f32x4 v0 = {0.f, 0.f, 0.f, 0.f}, v1 = v0, v2 = v0, v3 = v0;
    if (lane < ntok) { const GAS v4u* p = (const GAS v4u*)(projb + (size_t)(row0 + lane) * NPROJ + g * 16); const v4u a = p[0], b = p[1]; unpack8(a, v0, v1); unpack8(b, v2, v3); }
    LAS f32x4* o = (LAS f32x4*)(U + lane * 16); o[0] = v0; o[1] = v1; o[2] = v2; o[3] = v3;
}
struct SsmCoef { float lr, li; float br[16], bi[16]; };
__device__ __forceinline__ void ssm_load_coef(const float* sd, int g, int lane, SsmCoef& c) {
    const int idx = g * 64 + lane; c.lr = sd[SD_LBR + idx]; c.li = sd[SD_LBI + idx];
#pragma unroll
    for (int q = 0; q < 4; ++q) { const f32x4 a = *(const GAS f32x4*)(sd + SD_BBR + idx * 16 + 4 * q), b = *(const GAS f32x4*)(sd + SD_BBI + idx * 16 + 4 * q);
#pragma unroll
        for (int e = 0; e < 4; ++e) { c.br[4 * q + e] = a[e]; c.bi[4 * q + e] = b[e]; } }
}
__device__ __forceinline__ void ssm_step(const SsmCoef& c, const LAS float* Ut, float& hr, float& hi) {
    const LAS f32x4* up = (const LAS f32x4*)Ut; float br4[4], bi4[4];
#pragma unroll
    for (int q = 0; q < 4; ++q) { const f32x4 u = up[q];
        br4[q] = fmaf(u[3], c.br[4 * q + 3], fmaf(u[2], c.br[4 * q + 2], fmaf(u[1], c.br[4 * q + 1], u[0] * c.br[4 * q])));
        bi4[q] = fmaf(u[3], c.bi[4 * q + 3], fmaf(u[2], c.bi[4 * q + 2], fmaf(u[1], c.bi[4 * q + 1], u[0] * c.bi[4 * q]))); }
    const float bur = (br4[0] + br4[1]) + (br4[2] + br4[3]), bui = (bi4[0] + bi4[1]) + (bi4[2] + bi4[3]);
    const float nr = fmaf(c.lr, hr, fmaf(-c.li, hi, bur)), ni = fmaf(c.lr, hi, fmaf(c.li, hr, bui)); hr = nr; hi = ni;
}
__device__ __forceinline__ void ssm_pass1(const Args& a, LAS unsigned char* lds, int gw, int NGW, int wave, int lane) {
    unsigned char* ws = a.ws; const bf16* projb = (const bf16*)(ws + WS_PROJ); const float* sd = (const float*)(ws + WS_SSMD); float* SST = (float*)(ws + WS_SST);
    LAS float* U = (LAS float*)(lds + wave * 8192);
    for (int gi = gw; gi < 4 * 32 * 16; gi += NGW) { const int cq = gi & 15, bg = gi >> 4, g = bg & 31, b = bg >> 5;
        SsmCoef c; ssm_load_coef(sd, g, lane, c);
#pragma unroll 1
        for (int k = 0; k < 4; ++k) { const int chunk = 4 * cq + k;
            ssm_stage_u(projb, b * SEQ + chunk * 64, 64, g, U, lane); LDS_WAIT();
            float hr = 0.f, hi = 0.f;
#pragma unroll 4
            for (int t = 0; t < 64; ++t) ssm_step(c, U + t * 16, hr, hi);
            SST[(size_t)(bg * 64 + chunk) * 128 + lane] = hr; SST[(size_t)(bg * 64 + chunk) * 128 + 64 + lane] = hi;
            LDS_WAIT(); asm volatile("" ::: "memory"); }
    }
}
__device__ __forceinline__ void ssm_pass3(const Args& a, LAS unsigned char* lds, int gw, int NGW, int wave, int lane) {
    unsigned char* ws = a.ws; const bf16* projb = (const bf16*)(ws + WS_PROJ); const float* sd = (const float*)(ws + WS_SSMD); const float* SST = (const float*)(ws + WS_SST);
    bf16* zb = (bf16*)(ws + WS_ZB);
    LAS float* U = (LAS float*)(lds + wave * 8192); LAS unsigned* H = (LAS unsigned*)(lds + wave * 8192 + 4096);
    const int ch = lane & 15, kq = lane >> 4;
    for (int it = gw; it < 2048 + 4096; it += NGW) {
        int g, row0, ntok, nchunk, chunk0 = 0, bg; float hr = 0.f, hi = 0.f;
        if (it < 2048) { const int cq = it & 15; bg = it >> 4; g = bg & 31; chunk0 = 4 * cq; row0 = (bg >> 5) * SEQ + chunk0 * 64; ntok = 64; nchunk = 4;
            const float pr = sd[SD_PR + g * 64 + lane], pi = sd[SD_PI + g * 64 + lane]; const float* sp = SST + (size_t)(bg * 64) * 128 + lane;
            for (int j0 = 0; j0 < chunk0; j0 += 4) { float sr[4], si[4];
#pragma unroll
                for (int j = 0; j < 4; ++j) { sr[j] = sp[(j0 + j) * 128]; si[j] = sp[(j0 + j) * 128 + 64]; }
#pragma unroll
                for (int j = 0; j < 4; ++j) { const float nr = fmaf(pr, hr, fmaf(-pi, hi, sr[j])), ni = fmaf(pr, hi, fmaf(pi, hr, si[j])); hr = nr; hi = ni; } } }
        else { bg = it - 2048; g = bg & 31; row0 = MP + (bg >> 5) * DSEQ; ntok = 8; nchunk = 1; hr = a.in[6][(size_t)bg * 64 + lane]; hi = a.in[7][(size_t)bg * 64 + lane]; }
        SsmCoef c; ssm_load_coef(sd, g, lane, c);
        bf16x8 cm[4];
#pragma unroll
        for (int s = 0; s < 4; ++s) { const int n0 = 16 * s + 4 * kq; const f32x4 cr = *(const GAS f32x4*)(a.in[25] + (size_t)(g * 16 + ch) * 64 + n0), ci = *(const GAS f32x4*)(a.in[26] + (size_t)(g * 16 + ch) * 64 + n0);
            v4u w; w.x = pk2(cr[0], -ci[0]); w.y = pk2(cr[1], -ci[1]); w.z = pk2(cr[2], -ci[2]); w.w = pk2(cr[3], -ci[3]); cm[s] = __builtin_bit_cast(bf16x8, w); }
        const float dch = a.in[27][g * 16 + ch];
        const int nblk = ntok == 64 ? 4 : 1, ntt = ntok == 64 ? 16 : 8;
#pragma unroll 1
        for (int kc = 0; kc < nchunk; ++kc) { const int rowc = row0 + kc * 64;
            ssm_stage_u(projb, rowc, ntok, g, U, lane); LDS_WAIT();
            for (int tb = 0; tb < nblk; ++tb) {
#pragma unroll 4
                for (int tt = 0; tt < ntt; ++tt) { ssm_step(c, U + (tb * 16 + tt) * 16, hr, hi); H[tt * 64 + lane] = pk2(hr, hi); }
                LDS_WAIT();
                f32x4 acc = {0.f, 0.f, 0.f, 0.f};
#pragma unroll
                for (int s = 0; s < 4; ++s) { const bf16x8 af = *(const LAS bf16x8*)(H + ch * 64 + 16 * s + 4 * kq); acc = __builtin_amdgcn_mfma_f32_16x16x32_bf16(af, cm[s], acc, 0, 0, 0); }
#pragma unroll
                for (int i = 0; i < 4; ++i) { const int tok = tb * 16 + 4 * kq + i;
                    if (tok < ntok) { const float y = acc[i] + dch * U[tok * 16 + ch]; zb[(size_t)(rowc + tok) * 512 + g * 16 + ch] = (bf16)f2bf(gelu_tanh_f(y)); } }
                LDS_WAIT(); asm volatile("" ::: "memory");
            } }
        if (it >= 2048) { a.out[O_HRE_S + (size_t)bg * 64 + lane] = hr; a.out[O_HIM_S + (size_t)bg * 64 + lane] = hi; }
        else if (chunk0 == 60) { a.out[O_HRE_P + (size_t)bg * 64 + lane] = hr; a.out[O_HIM_P + (size_t)bg * 64 + lane] = hi; }
    }
}
}
namespace mk {
struct Cx { float r, i; };
__device__ __forceinline__ Cx cmul(Cx a, Cx b) { return {a.r * b.r - a.i * b.i, a.r * b.i + a.i * b.r}; }
__device__ __forceinline__ Cx cfma(Cx a, Cx b, Cx c) { return {fmaf(a.r, b.r, fmaf(-a.i, b.i, c.r)), fmaf(a.r, b.i, fmaf(a.i, b.r, c.i))}; }
struct SsmBlk { bf16x8 bre, bim; Cx p1, p2, p3, p4; };
__device__ __forceinline__ void ssm2_load_blk(const float* sd, int g, int nb, int r32, int hi, SsmBlk& k) {
    const int idx = g * 64 + 32 * nb + r32;
    const float* br = sd + SD_BBR + idx * 16 + 8 * hi; const float* bi = sd + SD_BBI + idx * 16 + 8 * hi;
    const f32x4 a0 = *(const GAS f32x4*)br, a1 = *(const GAS f32x4*)(br + 4), b0 = *(const GAS f32x4*)bi, b1 = *(const GAS f32x4*)(bi + 4);
    k.bre = __builtin_bit_cast(bf16x8, pack8(a0, a1)); k.bim = __builtin_bit_cast(bf16x8, pack8(b0, b1));
    k.p1 = {sd[SD_LBR + idx], sd[SD_LBI + idx]}; k.p2 = cmul(k.p1, k.p1); k.p3 = cmul(k.p2, k.p1); k.p4 = cmul(k.p2, k.p2);
}
template <bool CORRECT>
__device__ __forceinline__ void ssm2_scan(f32x16& X, f32x16& Y, const SsmBlk& k, Cx& c, int hi) {
#pragma unroll
    for (int q = 0; q < 4; ++q)
#pragma unroll
        for (int j = 1; j < 4; ++j) { const Cx h = cfma(k.p1, {X[4 * q + j - 1], Y[4 * q + j - 1]}, {X[4 * q + j], Y[4 * q + j]}); X[4 * q + j] = h.r; Y[4 * q + j] = h.i; }
    Cx cin[4];
#pragma unroll
    for (int q = 0; q < 4; ++q) {
        Cx le0, le1;
        xhalf_both(X[4 * q + 3], le0.r, le1.r); xhalf_both(Y[4 * q + 3], le0.i, le1.i);
        const Cx ca = c, cb = cfma(k.p4, ca, le0);
        c = cfma(k.p4, cb, le1);
        cin[q] = hi ? cb : ca; }
    if (CORRECT) {
#pragma unroll
        for (int q = 0; q < 4; ++q) { const Cx t0 = cmul(k.p1, cin[q]), t1 = cmul(k.p2, cin[q]), t2 = cmul(k.p3, cin[q]), t3 = cmul(k.p4, cin[q]);
            X[4 * q] += t0.r; Y[4 * q] += t0.i; X[4 * q + 1] += t1.r; Y[4 * q + 1] += t1.i; X[4 * q + 2] += t2.r; Y[4 * q + 2] += t2.i; X[4 * q + 3] += t3.r; Y[4 * q + 3] += t3.i; } }
}
__device__ __forceinline__ bf16x8 ssm2_ufrag(const bf16* projb, int row0, int ntok, int g, int r32, int hi) {
    v4u w = {0u, 0u, 0u, 0u};
    if (r32 < ntok) w = *(const GAS v4u*)(projb + (size_t)(row0 + r32) * NPROJ + g * 16 + 8 * hi);
    return __builtin_bit_cast(bf16x8, w);
}
#define SSM_MFMA32(a, b, c) __builtin_amdgcn_mfma_f32_32x32x16_bf16(a, b, c, 0, 0, 0)
__device__ __forceinline__ void ssm2_pass1(const Args& a, int gw, int NGW, int lane) {
    unsigned char* ws = a.ws; const bf16* projb = (const bf16*)(ws + WS_PROJ); const float* sd = (const float*)(ws + WS_SSMD); float* SST = (float*)(ws + WS_SST);
    const int r32 = lane & 31, hi = lane >> 5;
    for (int gi = gw; gi < 4 * 32 * 16; gi += NGW) { const int cq = gi & 15, bg = gi >> 4, g = bg & 31, b = bg >> 5;
        SsmBlk k0, k1; ssm2_load_blk(sd, g, 0, r32, hi, k0); ssm2_load_blk(sd, g, 1, r32, hi, k1);
#pragma unroll 1
        for (int kc = 0; kc < 4; ++kc) { const int chunk = 4 * cq + kc; Cx c0 = {0.f, 0.f}, c1 = {0.f, 0.f};
#pragma unroll
            for (int blk = 0; blk < 2; ++blk) { const bf16x8 uf = ssm2_ufrag(projb, b * SEQ + chunk * 64 + 32 * blk, 32, g, r32, hi);
                { f32x16 X = SSM_MFMA32(uf, k0.bre, f32x16{}), Y = SSM_MFMA32(uf, k0.bim, f32x16{}); ssm2_scan<false>(X, Y, k0, c0, hi); }
                { f32x16 X = SSM_MFMA32(uf, k1.bre, f32x16{}), Y = SSM_MFMA32(uf, k1.bim, f32x16{}); ssm2_scan<false>(X, Y, k1, c1, hi); } }
            float* sp = SST + (size_t)(bg * 64 + chunk) * 128;
            if (hi == 0) { sp[r32] = c0.r; sp[64 + r32] = c0.i; } else { sp[32 + r32] = c1.r; sp[96 + r32] = c1.i; } }
    }
}
__device__ __forceinline__ void ssm2_pass3(const Args& a, LAS unsigned char* lds, int gw, int NGW, int wave, int lane) {
    unsigned char* ws = a.ws; const bf16* projb = (const bf16*)(ws + WS_PROJ); const float* sd = (const float*)(ws + WS_SSMD); const float* SST = (const float*)(ws + WS_SST);
    bf16* zb = (bf16*)(ws + WS_ZB);
    LAS unsigned* H = (LAS unsigned*)(lds + wave * 16384);
    LAS bf16* U16 = (LAS bf16*)(lds + wave * 16384 + 8192);
    const int r32 = lane & 31, hi = lane >> 5, ch = lane & 15, kq = lane >> 4;
    for (int it = gw; it < 2048 + 4096; it += NGW) {
        int g, row0, ntok, nblk, chunk0 = 0, bg; Cx c0 = {0.f, 0.f}, c1 = {0.f, 0.f};
        SsmBlk k0, k1;
        if (it < 2048) { const int cq = it & 15; bg = it >> 4; g = bg & 31; chunk0 = 4 * cq; row0 = (bg >> 5) * SEQ + chunk0 * 64; ntok = 32; nblk = 8;
            ssm2_load_blk(sd, g, 0, r32, hi, k0); ssm2_load_blk(sd, g, 1, r32, hi, k1);
            const Cx p0 = {sd[SD_PR + g * 64 + r32], sd[SD_PI + g * 64 + r32]}, p1 = {sd[SD_PR + g * 64 + 32 + r32], sd[SD_PI + g * 64 + 32 + r32]};
            const float* sp = SST + (size_t)(bg * 64) * 128 + r32;
            for (int j0 = 0; j0 < chunk0; j0 += 4) { Cx s0[4], s1[4];
#pragma unroll
                for (int j = 0; j < 4; ++j) { s0[j] = {sp[(j0 + j) * 128], sp[(j0 + j) * 128 + 64]}; s1[j] = {sp[(j0 + j) * 128 + 32], sp[(j0 + j) * 128 + 96]}; }
#pragma unroll
                for (int j = 0; j < 4; ++j) { c0 = cfma(p0, c0, s0[j]); c1 = cfma(p1, c1, s1[j]); } } }
        else { bg = it - 2048; g = bg & 31; row0 = MP + (bg >> 5) * DSEQ; ntok = 8; nblk = 1;
            ssm2_load_blk(sd, g, 0, r32, hi, k0); ssm2_load_blk(sd, g, 1, r32, hi, k1);
            c0 = {a.in[6][(size_t)bg * 64 + r32], a.in[7][(size_t)bg * 64 + r32]}; c1 = {a.in[6][(size_t)bg * 64 + 32 + r32], a.in[7][(size_t)bg * 64 + 32 + r32]}; }
        bf16x8 cm[4];
#pragma unroll
        for (int s = 0; s < 4; ++s) { const int n0 = 16 * s + 4 * kq; const f32x4 cr = *(const GAS f32x4*)(a.in[25] + (size_t)(g * 16 + ch) * 64 + n0), ci = *(const GAS f32x4*)(a.in[26] + (size_t)(g * 16 + ch) * 64 + n0);
            v4u w; w.x = pk2(cr[0], -ci[0]); w.y = pk2(cr[1], -ci[1]); w.z = pk2(cr[2], -ci[2]); w.w = pk2(cr[3], -ci[3]); cm[s] = __builtin_bit_cast(bf16x8, w); }
        const float dch = a.in[27][g * 16 + ch];
        Cx e0 = c0, e1 = c1;
#pragma unroll 1
        for (int blk = 0; blk < nblk; ++blk) { const int rowb = row0 + 32 * blk;
            const bf16x8 uf = ssm2_ufrag(projb, rowb, ntok, g, r32, hi);
            *(LAS bf16x8*)(U16 + r32 * 16 + 8 * hi) = uf;
            { f32x16 X = SSM_MFMA32(uf, k0.bre, f32x16{}), Y = SSM_MFMA32(uf, k0.bim, f32x16{}); ssm2_scan<true>(X, Y, k0, c0, hi);
              if (hi == 1) e0 = {X[3], Y[3]};
#pragma unroll
              for (int r = 0; r < 16; ++r) H[((r & 3) + 8 * (r >> 2) + 4 * hi) * 64 + r32] = pg8::cvt_pk_bf16(X[r], Y[r]); }
            { f32x16 X = SSM_MFMA32(uf, k1.bre, f32x16{}), Y = SSM_MFMA32(uf, k1.bim, f32x16{}); ssm2_scan<true>(X, Y, k1, c1, hi);
              if (hi == 1) e1 = {X[3], Y[3]};
#pragma unroll
              for (int r = 0; r < 16; ++r) H[((r & 3) + 8 * (r >> 2) + 4 * hi) * 64 + 32 + r32] = pg8::cvt_pk_bf16(X[r], Y[r]); }
            LDS_WAIT();
#pragma unroll
            for (int tb = 0; tb < 2; ++tb) { f32x4 acc = {0.f, 0.f, 0.f, 0.f};
#pragma unroll
                for (int s = 0; s < 4; ++s) { const bf16x8 af = *(const LAS bf16x8*)(H + (16 * tb + ch) * 64 + 16 * s + 4 * kq); acc = __builtin_amdgcn_mfma_f32_16x16x32_bf16(af, cm[s], acc, 0, 0, 0); }
#pragma unroll
                for (int i = 0; i < 4; ++i) { const int tok = 16 * tb + 4 * kq + i;
                    if (tok < ntok) { const float y = acc[i] + dch * bf1(U16[tok * 16 + ch]); zb[(size_t)(rowb + tok) * 512 + g * 16 + ch] = (bf16)f2bf(gelu_tanh_f(y)); } } }
            LDS_WAIT(); asm volatile("" ::: "memory");
        }
        if (it >= 2048) { if (hi == 1) { a.out[O_HRE_S + (size_t)bg * 64 + r32] = e0.r; a.out[O_HIM_S + (size_t)bg * 64 + r32] = e0.i; a.out[O_HRE_S + (size_t)bg * 64 + 32 + r32] = e1.r; a.out[O_HIM_S + (size_t)bg * 64 + 32 + r32] = e1.i; } }
        else if (chunk0 == 60 && hi == 0) { a.out[O_HRE_P + (size_t)bg * 64 + r32] = c0.r; a.out[O_HIM_P + (size_t)bg * 64 + r32] = c0.i; a.out[O_HRE_P + (size_t)bg * 64 + 32 + r32] = c1.r; a.out[O_HIM_P + (size_t)bg * 64 + 32 + r32] = c1.i; }
    }
}
}
namespace attn {
constexpr int KSLOT = 12288, VSLOT = 8192, L_K = 0, L_V = 3 * KSLOT, L_WS = L_V + 3 * VSLOT, L_OST = L_WS + 8 * 256, L_END = L_OST + 8 * 4096;
static_assert(L_END <= mk::RING_BYTES, "attention LDS map");
constexpr int SEQ = 4096, DMK = 768, DMV = 512, DMO = 512;
constexpr float C2 = 0.10206207261596577f * 1.4426950408889634f;
#define A_MFMA(a, b, c) __builtin_amdgcn_mfma_f32_32x32x16_bf16(a, b, c, 0, 0, 0)
#define A_WAIT_BAR(N) asm volatile("s_waitcnt vmcnt(" #N ") lgkmcnt(0)\n\ts_barrier" ::: "memory")
__device__ __forceinline__ int crow(int r, int hi) { return (r & 3) + 8 * (r >> 2) + 4 * hi; }
__device__ __forceinline__ unsigned cvtpk(float lo, float hi) { unsigned r; asm("v_cvt_pk_bf16_f32 %0, %1, %2" : "=v"(r) : "v"(lo), "v"(hi)); return r; }
__device__ __forceinline__ void glds16(const void* g, unsigned lds_base) {
    unsigned sv; asm volatile("s_mov_b32 %0, m0\n\ts_mov_b32 m0, %2\n\ts_nop 0\n\tglobal_load_lds_dwordx4 %1, off\n\ts_mov_b32 m0, %0" : "=&s"(sv) : "v"(g), "s"(lds_base) : "memory"); }
typedef __attribute__((address_space(3))) const char* lds_cptr;
typedef short v4i16_t __attribute__((ext_vector_type(4)));
__device__ __forceinline__ s16x4 vtr(lds_cptr p) { return __builtin_bit_cast(s16x4, __builtin_amdgcn_ds_read_tr16_b64_v4i16((__attribute__((address_space(3))) v4i16_t*)p)); }

__device__ __forceinline__ void prompt_unit(int b, int h, int qb, const bf16* Q, const bf16* __restrict__ K, const bf16* __restrict__ V, bf16* O, const float* cs, float negB, char* lds) {
    const int tid = threadIdx.x, lane = tid & 63, r32 = lane & 31, hi = lane >> 5; const int wid = __builtin_amdgcn_readfirstlane(tid >> 6);
    const long rowbase = (long)b * SEQ; const int q0 = qb * 256, NT = (q0 + 256) / 64;
    const unsigned lds0 = (unsigned)(uintptr_t)lds; float* wsf = (float*)(lds + L_WS) + wid * 64;
    const bf16* ksrcA = K + rowbase * DMK + h * 96 + (long)lane * DMK + wid * 8;
    const bf16* ksrcB = K + rowbase * DMK + h * 96 + (long)lane * DMK + (8 + (wid & 3)) * 8;
    const bf16* vsrc = V + rowbase * DMV + h * 64 + (long)(16 * (wid & 3) + (lane >> 2)) * DMV + (wid >> 2) * 32 + (lane & 3) * 8;
    const unsigned kdstA = lds0 + L_K + wid * 1024, kdstB = lds0 + L_K + (8 + (wid & 3)) * 1024, vdst = lds0 + L_V + wid * 1024;
#define A_DMA(t, s) do { glds16(ksrcA + (long)(t) * 64 * DMK, (unsigned)__builtin_amdgcn_readfirstlane(kdstA + (s) * KSLOT)); glds16(ksrcB + (long)(t) * 64 * DMK, (unsigned)__builtin_amdgcn_readfirstlane(kdstB + (s) * KSLOT)); \
                         glds16(vsrc + (long)(t) * 64 * DMV, (unsigned)__builtin_amdgcn_readfirstlane(vdst + (s) * VSLOT)); } while (0)
    const lds_cptr vp0 = (lds_cptr)lds + L_V + ((lane >> 4) & 1) * 32 + (lane & 3) * 8 + (4 * hi + ((lane & 15) >> 2)) * 64;
    const lds_cptr kp0 = (lds_cptr)lds + L_K + hi * 1024 + r32 * 16;
    A_DMA(0, 0); A_DMA(1, 1);
    bf16x8 qr[6];
    { const long row = rowbase + q0 + wid * 32 + r32; const bf16* qp = Q + row * 768 + h * 96 + 8 * hi;
      v4u w[6];
#pragma unroll
      for (int s = 0; s < 6; ++s) w[s] = *(const GAS v4u*)(qp + 16 * s);
      float ss = 0.f;
#pragma unroll
      for (int s = 0; s < 6; ++s) ss += mk::sq8(w[s]);
      ss += __shfl_xor(ss, 32);
      const float rn = rsq(ss * (1.f / 96.f) + mk::EPS) * C2;
#pragma unroll
      for (int s = 0; s < 4; ++s) { f32x4 a, c; mk::unpack8(w[s], a, c); qr[s] = __builtin_bit_cast(bf16x8, mk::pack8(a * rn, c * rn)); }
      const float* csr = cs + (size_t)(q0 + wid * 32 + r32) * 32 + 8 * hi;
      f32x4 x1a, x1b, x2a, x2b; mk::unpack8(w[4], x1a, x1b); mk::unpack8(w[5], x2a, x2b);
      const f32x4 ca = *(const GAS f32x4*)csr, cb = *(const GAS f32x4*)(csr + 4), sa = *(const GAS f32x4*)(csr + 16), sb = *(const GAS f32x4*)(csr + 20);
      qr[4] = __builtin_bit_cast(bf16x8, mk::pack8((x1a * ca - x2a * sa) * rn, (x1b * cb - x2b * sb) * rn));
      qr[5] = __builtin_bit_cast(bf16x8, mk::pack8((x2a * ca + x1a * sa) * rn, (x2b * cb + x1b * sb) * rn)); }
    f32x16 o0 = f32x16{}, o1 = f32x16{}; float l_reg = 0.f;
    f32x16 nb16;
#pragma unroll
    for (int r = 0; r < 16; ++r) nb16[r] = negB;
    const int qrel = wid * 32 + r32;
    int slot = 0;
    for (int t = 0; t < NT; ++t) {
        if (t + 1 < NT) { A_WAIT_BAR(3); } else { A_WAIT_BAR(0); }
        if (t + 2 < NT) { const int s2 = slot >= 1 ? slot - 1 : 2; A_DMA(t + 2, s2); }
        const lds_cptr kp = kp0 + slot * KSLOT; const lds_cptr vp_ = vp0 + slot * VSLOT;
        f32x16 p0 = nb16, p1 = nb16;
#pragma unroll
        for (int s = 0; s < 6; ++s) { const bf16x8 ka = *(const __attribute__((address_space(3))) bf16x8*)(kp + s * 2048), kb = *(const __attribute__((address_space(3))) bf16x8*)(kp + s * 2048 + 512);
            p0 = A_MFMA(ka, qr[s], p0); p1 = A_MFMA(kb, qr[s], p1); }
        if (t >= NT - 4) { const int kb0 = 64 * (t - (NT - 4)) + 4 * hi;
#pragma unroll
            for (int r = 0; r < 16; ++r) { const int kv = kb0 + (r & 3) + 8 * (r >> 2); if (kv > qrel) p0[r] = -INFINITY; if (kv + 32 > qrel) p1[r] = -INFINITY; } }
        float sacc = 0.f;
#pragma unroll
        for (int r = 0; r < 16; ++r) { p0[r] = __builtin_amdgcn_exp2f(p0[r]); p1[r] = __builtin_amdgcn_exp2f(p1[r]); sacc += p0[r] + p1[r]; }
        l_reg += sacc;
        v4u pw[4];
        pw[0] = (v4u){cvtpk(p0[0], p0[1]), cvtpk(p0[2], p0[3]), cvtpk(p0[4], p0[5]), cvtpk(p0[6], p0[7])};
        pw[1] = (v4u){cvtpk(p0[8], p0[9]), cvtpk(p0[10], p0[11]), cvtpk(p0[12], p0[13]), cvtpk(p0[14], p0[15])};
        pw[2] = (v4u){cvtpk(p1[0], p1[1]), cvtpk(p1[2], p1[3]), cvtpk(p1[4], p1[5]), cvtpk(p1[6], p1[7])};
        pw[3] = (v4u){cvtpk(p1[8], p1[9]), cvtpk(p1[10], p1[11]), cvtpk(p1[12], p1[13]), cvtpk(p1[14], p1[15])};
#pragma unroll
        for (int i = 0; i < 8; ++i) { const s16x4 vlo = vtr(vp_ + ((i >> 2) * 4096 + (i & 3) * 1024)), vhi = vtr(vp_ + ((i >> 2) * 4096 + (i & 3) * 1024 + 512));
            const bf16x8 vf = (bf16x8){vlo[0], vlo[1], vlo[2], vlo[3], vhi[0], vhi[1], vhi[2], vhi[3]};
            if (i < 4) o0 = A_MFMA(__builtin_bit_cast(bf16x8, pw[i & 3]), vf, o0); else o1 = A_MFMA(__builtin_bit_cast(bf16x8, pw[i & 3]), vf, o1); }
        slot = slot == 2 ? 0 : slot + 1;
    }
    l_reg += __shfl_xor(l_reg, 32);
    if (hi == 0) wsf[r32] = l_reg;
    asm volatile("s_waitcnt lgkmcnt(0)" ::: "memory");
    bf16* Ow = O + (rowbase + q0 + wid * 32) * DMO + h * 64; bf16* stg = (bf16*)(lds + L_OST) + wid * 2048;
#pragma unroll
    for (int r = 0; r < 16; ++r) { const int orow = crow(r, hi); const float rl = __builtin_amdgcn_rcpf(wsf[orow]);
        stg[orow * 64 + r32] = (bf16)f2bf(o0[r] * rl); stg[orow * 64 + 32 + r32] = (bf16)f2bf(o1[r] * rl); }
    asm volatile("s_waitcnt lgkmcnt(0)" ::: "memory");
#pragma unroll
    for (int i = 0; i < 4; ++i) { const int row = i * 8 + (lane >> 3), chn = lane & 7; *(v4u*)(Ow + (long)row * DMO + chn * 8) = *(const v4u*)(stg + row * 64 + chn * 8); }
    asm volatile("s_waitcnt vmcnt(0) lgkmcnt(0)\n\ts_barrier" ::: "memory");
#undef A_DMA
}
}
namespace sattn {
using attn::crow; using attn::cvtpk; using attn::vtr; using attn::lds_cptr;
constexpr int CS = 1040;
constexpr int IMG_SLOT = 36 * CS, KPE_OFF = 32 * CS;
constexpr int S_IMG = 0, S_QA = 3 * IMG_SLOT, S_PX = S_QA + 16384, S_RKP = S_PX + 8192, S_KSS = S_RKP + 2048, S_QR = S_KSS + 3 * 256, S_END = S_QR + 2048;
constexpr int S_QT = IMG_SLOT;
static_assert(S_END <= mk::LDSCTL_OFF, "sample attention LDS map");
#define S_MFMA(a, b, c) __builtin_amdgcn_mfma_f32_32x32x16_bf16(a, b, c, 0, 0, 0)
typedef __attribute__((address_space(3))) bf16x8 lbf16x8;
typedef __attribute__((address_space(3))) f32x4 lf32x4;
typedef __attribute__((address_space(3))) v4u lv4u;
typedef __attribute__((address_space(3))) v2u lv2u;
typedef __attribute__((address_space(3))) float lfloat;
#define S_BAR() asm volatile("s_waitcnt lgkmcnt(0)\n\ts_barrier" ::: "memory")
#define S_BARV() asm volatile("s_waitcnt vmcnt(0) lgkmcnt(0)\n\ts_barrier" ::: "memory")

__device__ __forceinline__ void sample_unit(const mk::Args& a, int seq, int hh, float negB, char* lds) {
    using namespace mk;
    const int tid = threadIdx.x, lane = tid & 63, r32 = lane & 31, hi = lane >> 5; const int wid = __builtin_amdgcn_readfirstlane(tid >> 6);
    unsigned char* ws = a.ws;
    const int* pt = (const int*)a.in[8] + seq * 64;
    const float* cache_ckv = a.in[4]; const float* cache_kpe = a.in[5];
    constexpr int NTC = 128, NT = NTC + 1;
    f32x4 pfa[8]; f32x4 pfka;
    const int ptv = pt[lane];
#define S_LOAD(t, pf, pfk) do { const int key0_ = (t) * 64; const int page_ = __builtin_amdgcn_readlane(ptv, key0_ >> 7); const size_t prow_ = (size_t)page_ * 128 + (key0_ & 127) + 8 * wid; \
        const float* cs_ = cache_ckv + prow_ * 256 + lane * 4;                  \
        _Pragma("unroll") for (int i_ = 0; i_ < 8; ++i_) pf[i_] = *(const GAS f32x4*)(cs_ + i_ * 256); \
        pfk = *(const GAS f32x4*)(cache_kpe + (prow_ + (lane >> 3)) * 32 + (lane & 7) * 4); } while (0)
#define S_CONVERT(slot, pf, pfk) do { char* ib_ = lds + S_IMG + (slot) * IMG_SLOT; const int chn_ = lane >> 1; \
        _Pragma("unroll") for (int i_ = 0; i_ < 8; ++i_) { const int key_ = 8 * wid + i_; v2u w2_; w2_.x = pg8::cvt_pk_bf16(pf[i_][0], pf[i_][1]); w2_.y = pg8::cvt_pk_bf16(pf[i_][2], pf[i_][3]); \
            *(lv2u*)(ib_ + chn_ * CS + key_ * 16 + (lane & 1) * 8) = w2_; } \
        { const int key_ = 8 * wid + (lane >> 3), seg_ = lane & 7; float s_ = (pfk[0] * pfk[0] + pfk[1] * pfk[1]) + (pfk[2] * pfk[2] + pfk[3] * pfk[3]); \
          s_ = sum8_dpp(s_); \
          v2u w_; w_.x = pk2(pfk[0], pfk[1]); w_.y = pk2(pfk[2], pfk[3]); *(lv2u*)(ib_ + KPE_OFF + (seg_ >> 1) * CS + key_ * 16 + (seg_ & 1) * 8) = w_; \
          if (seg_ == 0) *(lfloat*)(lds + S_KSS + (slot) * 256 + key_ * 4) = s_; } } while (0)
    S_LOAD(0, pfa, pfka);
    for (int rep_su = 0; rep_su < REP_SETUP; ++rep_su) {
    LAS float* QT = (LAS float*)(lds + S_QT);
    {
      const int col = tid >> 4, sg = tid & 15, h = 4 * hh + (col >> 3), q = col & 7;
      const bf16* qp = (const bf16*)(ws + WS_QB) + (size_t)(MP + seq * 8 + q) * 768 + h * 96 + 6 * sg;
      const unsigned w0 = *(const GAS unsigned*)qp, w1 = *(const GAS unsigned*)(qp + 2), w2 = *(const GAS unsigned*)(qp + 4);
      const float v[6] = {bflo(w0), bfhi(w0), bflo(w1), bfhi(w1), bflo(w2), bfhi(w2)};
      float ss = (v[0] * v[0] + v[1] * v[1]) + (v[2] * v[2] + v[3] * v[3]) + (v[4] * v[4] + v[5] * v[5]);
      ss = sum8_dpp(ss); ss += __builtin_bit_cast(float, __builtin_amdgcn_update_dpp(0, __builtin_bit_cast(int, ss), 0x140, 0xF, 0xF, true));
      const float rn = rsq(ss * (1.f / 96.f) + EPS) * attn::C2;
#pragma unroll
      for (int e = 0; e < 6; ++e) QT[col * 96 + 6 * sg + e] = v[e] * rn; }
    __syncthreads();
    {
      const int col = tid >> 4, j = tid & 15, q = col & 7; const float* gt = (const float*)(ws + WS_GT); const float* csr = (const float*)(ws + WS_CS) + (size_t)(SEQ + q) * 32;
      LAS f32x4* np = (LAS f32x4*)(QT + col * 96 + 4 * j); const f32x4 g4 = *(const GAS f32x4*)(gt + 4 * j); *np = *np * g4;
      const float x1 = QT[col * 96 + 64 + j], x2 = QT[col * 96 + 80 + j], c = csr[j], sn = csr[16 + j], g = gt[64 + j];
      QT[col * 96 + 64 + j] = (x1 * c - x2 * sn) * g; QT[col * 96 + 80 + j] = (x2 * c + x1 * sn) * g; }
    __syncthreads();
    if (tid < 128) { const int col = tid & 31, chn = tid >> 5; const LAS float* s = QT + col * 96 + 64 + chn * 8;
        v4u w; w.x = pk2(s[0], s[1]); w.y = pk2(s[2], s[3]); w.z = pk2(s[4], s[5]); w.w = pk2(s[6], s[7]);
        *(lv4u*)(lds + S_QR + chn * 512 + col * 16) = w; }
    { const int col = tid & 31, cg = tid >> 5, h = 4 * hh + (col >> 3); const float* wuk = a.in[14];
      const LAS f32x4* qv = (const LAS f32x4*)(QT + col * 96);
#pragma unroll 1
      for (int cc = 0; cc < 2; ++cc) { unsigned wv[4];
#pragma unroll
          for (int e2 = 0; e2 < 4; ++e2) { const int c = cg * 16 + cc * 8 + 2 * e2; const GAS f32x4* wp0 = (const GAS f32x4*)(wuk + ((size_t)c * 8 + h) * 64); const GAS f32x4* wp1 = wp0 + 128; float s0 = 0.f, s1 = 0.f;
#pragma unroll 8
              for (int d4 = 0; d4 < 16; ++d4) { const f32x4 qq = qv[d4], w0 = wp0[d4], w1 = wp1[d4];
                  s0 += (w0[0] * qq[0] + w0[1] * qq[1]) + (w0[2] * qq[2] + w0[3] * qq[3]); s1 += (w1[0] * qq[0] + w1[1] * qq[1]) + (w1[2] * qq[2] + w1[3] * qq[3]); }
              wv[e2] = pk2(s0, s1); }
          *(lv4u*)(lds + S_QA + (cg * 2 + cc) * 512 + col * 16) = (v4u){wv[0], wv[1], wv[2], wv[3]}; } }
    S_BARV();
    }
    const int hl = wid & 3, rb = wid >> 2;
    bf16x8 wf[16];
    { const bf16* wt = (const bf16*)(ws + WS_WUKS) + (size_t)((4 * hh + hl) * 64 + 32 * rb + r32) * 256 + 8 * hi;
#pragma unroll
      for (int s = 0; s < 16; ++s) wf[s] = __builtin_bit_cast(bf16x8, *(const GAS v4u*)(wt + 16 * s)); }
    const int kb16 = wid >> 1, cb16 = wid & 1, l15 = lane & 15, g4 = lane >> 4;
    S_CONVERT(0, pfa, pfka);
    S_LOAD(1, pfa, pfka);
    S_BAR();
    const int fb0 = S_IMG + hi * CS + r32 * 16;
    const int sab = S_IMG + g4 * CS + (16 * kb16 + l15) * 16, skb = S_IMG + KPE_OFF + g4 * CS + (16 * kb16 + l15) * 16;
    const int sqb = S_QA + g4 * 512 + (16 * cb16 + l15) * 16, sqr = S_QR + g4 * 512 + (16 * cb16 + l15) * 16;
    const int chl = 2 * ((lane >> 4) & 1) + ((lane & 3) >> 1);
    const int vb = S_IMG + (4 * wid + chl) * CS + (lane & 1) * 8 + 16 * (4 * hi + ((lane & 15) >> 2));
    const int hcol = 2 * cb16 + (l15 >> 3), qcol = l15 & 7;
    f32x16 o0 = f32x16{}; float l_reg = 0.f; f32x4 sraw = {0.f, 0.f, 0.f, 0.f};
    int sl_n = 0, sl_p = 2;
#define SB0() __builtin_amdgcn_sched_barrier(0)
#define S_BLK_NORMS(t) do { if (t + 1 < NT) { const lds_cptr ib = (lds_cptr)lds + sl_n * IMG_SLOT; bf16x8 fa[4], fb[4]; \
        _Pragma("unroll") for (int j = 0; j < 4; ++j) fa[j] = *(const lbf16x8*)(ib + fb0 + 2 * CS * j); SB0(); \
        __builtin_amdgcn_s_setprio(1); \
        _Pragma("unroll") for (int kb = 0; kb < 2; ++kb) { f32x16 n0 = f32x16{}; \
          _Pragma("unroll") for (int gq = 0; gq < 4; ++gq) { \
            if (gq & 1) { if (gq < 3 || kb == 0) { _Pragma("unroll") for (int j = 0; j < 4; ++j) fa[j] = *(const lbf16x8*)(ib + fb0 + 2 * CS * ((4 * (gq + 1) + j) & 15) + 512 * (gq < 3 ? kb : 1)); } SB0(); \
                          _Pragma("unroll") for (int j = 0; j < 4; ++j) n0 = S_MFMA(wf[4 * gq + j], fb[j], n0); SB0(); } \
            else        { _Pragma("unroll") for (int j = 0; j < 4; ++j) fb[j] = *(const lbf16x8*)(ib + fb0 + 2 * CS * (4 * (gq + 1) + j) + 512 * kb); SB0(); \
                          _Pragma("unroll") for (int j = 0; j < 4; ++j) n0 = S_MFMA(wf[4 * gq + j], fa[j], n0); SB0(); } } \
          float s0 = 0.f; \
          _Pragma("unroll") for (int r = 0; r < 16; ++r) s0 += n0[r] * n0[r]; \
          s0 = xhalf_sum(s0); \
          if (hi == 0) *(lfloat*)(lds + S_RKP + ((rb * 4 + hl) * 64 + 32 * kb + r32) * 4) = s0; } \
        __builtin_amdgcn_s_setprio(0); } } while (0)
#define S_BLK_SCORES(t) do { if (t + 1 < NT) { const lds_cptr ib = (lds_cptr)lds + sl_n * IMG_SLOT; f32x4 sacc = {0.f, 0.f, 0.f, 0.f}; \
        _Pragma("unroll") \
        for (int s = 0; s < 8; ++s) { const bf16x8 fa_ = *(const lbf16x8*)(ib + sab + 4 * CS * s), fq_ = *(const lbf16x8*)((lds_cptr)lds + sqb + 2048 * s); sacc = __builtin_amdgcn_mfma_f32_16x16x32_bf16(fa_, fq_, sacc, 0, 0, 0); } \
        { const bf16x8 fa_ = *(const lbf16x8*)(ib + skb), fq_ = *(const lbf16x8*)((lds_cptr)lds + sqr); sacc = __builtin_amdgcn_mfma_f32_16x16x32_bf16(fa_, fq_, sacc, 0, 0, 0); } \
        sraw = sacc; } } while (0)
#define S_BLK_PV(t) do { if (t >= 0) { const lds_cptr ib = (lds_cptr)lds + sl_p * IMG_SLOT; const lds_cptr px = (lds_cptr)lds + S_PX + (t & 1) * 4096 + lane * 16; \
        _Pragma("unroll") \
            for (int k = 0; k < 4; ++k) { const s16x4 vlo = vtr(ib + vb + 256 * k), vhi = vtr(ib + vb + 256 * k + 128); \
                const bf16x8 vf = (bf16x8){vlo[0], vlo[1], vlo[2], vlo[3], vhi[0], vhi[1], vhi[2], vhi[3]}; \
                o0 = S_MFMA(*(const lbf16x8*)(px + k * 1024), vf, o0); } } } while (0)
#define S_BLK_CONV(t, PF, PFK) do { \
          if (t + 2 < NTC) { S_CONVERT(sl_w, PF, PFK); } \
          else if (t + 2 == NTC) { int tq = threadIdx.x; asm volatile("" : "+v"(tq)); \
              char* ib_ = lds + S_IMG + sl_w * IMG_SLOT; \
              if (tq < 256) { const int key = tq >> 5, chn = tq & 31; *(lv4u*)(ib_ + chn * CS + key * 16) = *(const GAS v4u*)((const bf16*)(ws + WS_CKVS) + (size_t)(seq * 8 + key) * 256 + chn * 8); } \
              if (tq < 32) { const int key = tq >> 2, chn = tq & 3; *(lv4u*)(ib_ + KPE_OFF + chn * CS + key * 16) = *(const GAS v4u*)((const bf16*)(ws + WS_KPES) + (size_t)(seq * 8 + key) * 32 + chn * 8); } \
              if (tq < 8) { const bf16* kp = (const bf16*)(ws + WS_KPES) + (size_t)(seq * 8 + tq) * 32; float s = 0.f; for (int i = 0; i < 32; ++i) { const float v = bf1(kp[i]); s += v * v; } \
                  *(lfloat*)(lds + S_KSS + sl_w * 256 + tq * 4) = s; } } \
          if (t + 3 < NTC) S_LOAD(t + 3, PF, PFK); } while (0)
#define S_TILE(t, PF, PFK) do { \
        const int sl_w = 3 - sl_n - sl_p; \
          \
        S_ORDER_BODY(t, PF, PFK); \
        S_BAR(); \
        if (t + 1 < NT) { const int kof = (16 * kb16 + 4 * g4) * 4; \
            const f32x4 p0 = *(const lf32x4*)(lds + S_RKP + hcol * 256 + kof), p1 = *(const lf32x4*)(lds + S_RKP + 1024 + hcol * 256 + kof), ks = *(const lf32x4*)(lds + S_KSS + sl_n * 256 + kof); \
            float p[4]; \
        _Pragma("unroll") \
            for (int e = 0; e < 4; ++e) { const float rk = rsq((p0[e] + p1[e] + ks[e]) * (1.f / 96.f) + EPS); p[e] = __builtin_amdgcn_exp2f(fmaf(sraw[e], rk, negB)); \
                if (t + 1 == NTC) { const int key = 16 * kb16 + 4 * g4 + e; if (key > qcol) p[e] = 0.f; } } \
            l_reg += (p[0] + p[1]) + (p[2] + p[3]); \
              \
            *(lv2u*)(lds + S_PX + ((t + 1) & 1) * 4096 + kb16 * 1024 + (16 * cb16 + l15 + 32 * (g4 & 1)) * 16 + 8 * (g4 >> 1)) = (v2u){cvtpk(p[0], p[1]), cvtpk(p[2], p[3])}; } \
        sl_p = sl_n; sl_n = sl_w; \
        S_BAR(); \
    } while (0)
    for (int t = -1; t < NT; ++t) { S_TILE(t, pfa, pfka); }
#undef S_BLK_NORMS
#undef S_BLK_SCORES
#undef S_BLK_PV
#undef S_BLK_CONV
#undef SB0
#undef S_TILE
    LAS float* OL = (LAS float*)(lds + S_IMG); LAS float* LL = (LAS float*)(lds + S_IMG + 32768);
    LL[wid * 64 + lane] = l_reg;
#pragma unroll
    for (int r = 0; r < 16; ++r) OL[crow(r, hi) * 256 + 32 * wid + r32] = o0[r];
    S_BAR();
    for (int rep_ep = 0; rep_ep < REP_EPI; ++rep_ep) { const float* wuv = a.in[15]; bf16* bout = (bf16*)(ws + WS_BOUT); asm volatile("" ::: "memory");
#pragma unroll 1
      for (int ci = 0; ci < 4; ++ci) { const int col = 4 * wid + ci, h = 4 * hh + (col >> 3), q = col & 7; float lsum = 0.f;
#pragma unroll
          for (int w8 = (col >> 4); w8 < 8; w8 += 2) for (int gg = 0; gg < 4; ++gg) lsum += LL[w8 * 64 + gg * 16 + (col & 15)];
          const float inv = 1.f / lsum;
          const LAS f32x4* lat = (const LAS f32x4*)(OL + col * 256); float acc = 0.f;
#pragma unroll 16
          for (int c4 = 0; c4 < 64; ++c4) { const f32x4 lv = lat[c4]; const float* wp = wuv + ((size_t)(4 * c4) * 8 + h) * 64 + lane;
              acc = fmaf(lv[0], wp[0], acc); acc = fmaf(lv[1], wp[512], acc); acc = fmaf(lv[2], wp[1024], acc); acc = fmaf(lv[3], wp[1536], acc); }
          bout[(size_t)(MP + seq * 8 + q) * 512 + h * 64 + lane] = (bf16)f2bf(acc * inv); } }
    S_BARV();
#undef S_LOAD
#undef S_CONVERT
}
}
namespace mk {
__global__ void __launch_bounds__(NWAVES * 64, 2) mk_fwd(Args args) {
    extern __shared__ __attribute__((aligned(16))) unsigned char lds_raw[];
    LAS unsigned char* lds = (LAS unsigned char*)lds_raw;
    volatile LAS unsigned* MISC = (volatile LAS unsigned*)(lds + MISC_OFF);
    const int tid = threadIdx.x, lane = tid & 63, wave = __builtin_amdgcn_readfirstlane(tid >> 6);
    const int G = gridDim.x; const int bx = blockIdx.x; const int vcu = (G % 8 == 0) ? (bx % 8) * (G / 8) + bx / 8 : bx;
    unsigned char* ws = args.ws;
    gu32* ctl = (gu32*)(ws + WS_CTL);
    for (int u = tid; u < (LDS_BYTES - LDSCTL_OFF) / 4; u += NWAVES * 64) ((LAS unsigned*)(lds + LDSCTL_OFF))[u] = 0u;
    __syncthreads();
    XcdBarrier bar = xcd_barrier_post((unsigned*)(ctl + CW_BAR), MISC + 8);
    const int lo = args.ph_lo, hi = args.ph_hi;
#define IN(k) (lo <= (k) && (k) < hi)
#define BOTH(k) (IN(k) && IN((k) + 1))
#define GRID_BAR() xcd_barrier(bar)
    float* ssq_q = (float*)(ws + CTL_SSQ_Q); float* ssq_kv = (float*)(ws + CTL_SSQ_KV); float* ssq_x1 = (float*)(ws + CTL_SSQ_X1); float* ssq_x2 = (float*)(ws + CTL_SSQ_X2);
    bf16* projb = (bf16*)(ws + WS_PROJ);

    if (IN(0)) { for (int rep = 0; rep < REP_P0; ++rep) { p0_prologue(args, lds, vcu, G, wave, lane); __syncthreads(); } if (BOTH(0)) GRID_BAR(); }

    if (IN(1)) {
        pg8::Gemm g{(const bf16*)(ws + WS_XB), (const bf16*)(ws + WS_WIN), M, NPROJ, 1024, 1024, 1024}; pg8::StaticOrder S; S.init(M, NPROJ, G, bx);
        EpiG1 E{projb, (const float*)(ws + WS_RX), ssq_q, ssq_kv};
        pg8::gemm_phase<EpiG1, pg8::StaticOrder, true, true>(lds, g, S, E);
#if REP_P1 > 1
        GRID_BAR(); for (int i = bx * 512 + tid; i < M; i += G * 512) { ssq_q[i] = 0.f; ssq_kv[i] = 0.f; } GRID_BAR();
        pg8::gemm_phase<EpiG1, pg8::StaticOrder, true, true>(lds, g, S, E);
#endif
        {
          const int nun = (M / 256) * (NPROJ / 256), rem = nun % G, nidle = rem ? G - rem : G, iidx = rem ? bx - rem : bx;
          if (iidx >= 0) { p0_weights<1>(args, lds, iidx * NWAVES + wave, nidle * NWAVES, wave, lane); __syncthreads(); } }
        if (BOTH(1)) GRID_BAR();
    }
    if (IN(2)) for (int rep_ph = 0; rep_ph < REP_P2; ++rep_ph) { if (rep_ph) __syncthreads();
        { pg8::Gemm g{projb + PC_Q, (const bf16*)(ws + WS_WUQ), M, 768, 384, NPROJ, 384}; pg8::StaticOrder S; S.init(M, 768, G, bx);
          EpiRowScale E{(bf16*)(ws + WS_QB), 768, ssq_q, 1.f / 384.f};
          pg8::gemm_phase<EpiRowScale, pg8::StaticOrder, true, true>(lds, g, S, E); }
        { pg8::Gemm g{projb + PC_KV, (const bf16*)(ws + WS_WUKV), M, 1024, 256, NPROJ, 256}; pg8::PromptPlusTail S; S.S.init(MP, 1024, G, bx); S.w0 = 204; S.bx = bx; S.pm0 = MP / 256;
          EpiKV E{(bf16*)(ws + WS_KB), (bf16*)(ws + WS_VB), ssq_kv, projb, (const float*)(ws + WS_CS), (const float*)(ws + WS_GT)};
          pg8::gemm_phase<EpiKV, pg8::PromptPlusTail, true, true>(lds, g, S, E); }
        for (int rep_e = 0; rep_e < REP_E1; ++rep_e) e1_rows(args, vcu * NWAVES + wave, G * NWAVES, lane);
        for (int rep_s = 0; rep_s < REP_SSM1; ++rep_s) ssm2_pass1(args, vcu * NWAVES + wave, G * NWAVES, lane);
        if (BOTH(2)) GRID_BAR();
    }
    if (IN(3)) {
        for (int rep = 0; rep < REP_SSM3; ++rep) { ssm2_pass3(args, lds, vcu * NWAVES + wave, G * NWAVES, wave, lane); __syncthreads(); }
        {
          const float negB = -((const float*)(ws + WS_GT))[80];
          for (int rep = 0; rep < REP_PATTN; ++rep) for (int p = vcu; p < 256; p += G) { const int bh = p >> 3, j = p & 7;
              attn::prompt_unit(bh >> 3, bh & 7, j, (const bf16*)(ws + WS_QB), (const bf16*)(ws + WS_KB), (const bf16*)(ws + WS_VB), (bf16*)(ws + WS_BOUT), (const float*)(ws + WS_CS), negB, (char*)lds_raw);
              attn::prompt_unit(bh >> 3, bh & 7, 15 - j, (const bf16*)(ws + WS_QB), (const bf16*)(ws + WS_KB), (const bf16*)(ws + WS_VB), (bf16*)(ws + WS_BOUT), (const float*)(ws + WS_CS), negB, (char*)lds_raw); } }
        {
          const float negB = -((const float*)(ws + WS_GT))[80];
          for (int rep = 0; rep < REP_SATTN; ++rep) for (int u = vcu; u < 256; u += G) sattn::sample_unit(args, TWIN_FAR ? (u & 127) : (u >> 1), TWIN_FAR ? (u >> 7) : (u & 1), negB, (char*)lds_raw); }
        if (BOTH(3)) GRID_BAR();
    }
    if (IN(4)) for (int rep_ph = 0; rep_ph < REP_P4; ++rep_ph) { if (rep_ph) __syncthreads();
        { pg8::Gemm g{(const bf16*)(ws + WS_ZB), (const bf16*)(ws + WS_WGLU), M, 512, 512, 512, 512}; pg8::StaticOrder S; S.init(M, 512, G, bx);
          EpiGate<0> E{(bf16*)(ws + WS_AOUT), 512, (const bf16*)(ws + WS_ZB), 512, 0, nullptr};
          pg8::gemm_phase<EpiGate<0>, pg8::StaticOrder, true, true>(lds, g, S, E); }
        { pg8::Gemm g{(const bf16*)(ws + WS_PB), (const bf16*)(ws + WS_WPLE), M, 1024, 256, 256, 256}; pg8::PromptPlusTail S; S.S.init(MP, 1024, G, bx); S.w0 = 136; S.bx = bx; S.pm0 = MP / 256;
          EpiRowScale E{(bf16*)(ws + WS_PW), 1024, nullptr, 0.f};
          pg8::gemm_phase<EpiRowScale, pg8::PromptPlusTail, true, true>(lds, g, S, E); }
        if (BOTH(4)) GRID_BAR();
    }
    if (IN(5)) for (int rep_ph = 0; rep_ph < REP_P5; ++rep_ph) { if (rep_ph) __syncthreads();
        { pg8::Gemm g{(const bf16*)(ws + WS_AOUT), (const bf16*)(ws + WS_WA), MP, 1024, 512, 512, 512}; pg8::StaticOrder S; S.init(MP, 1024, G, bx);
          EpiGate<1> E{(bf16*)(ws + WS_TMP), 1024, projb, NPROJ, PC_GA, nullptr};
          pg8::gemm_phase<EpiGate<1>, pg8::StaticOrder, true, true>(lds, g, S, E); }
        { pg8::Gemm g{(const bf16*)(ws + WS_BOUT), (const bf16*)(ws + WS_WB), MP, 1024, 512, 512, 512}; pg8::StaticOrder S; S.init(MP, 1024, G, bx);
          EpiGate<2> E{(bf16*)(ws + WS_MRG), 1024, projb, NPROJ, PC_GB, (const bf16*)(ws + WS_TMP)};
          pg8::gemm_phase<EpiGate<2>, pg8::StaticOrder, true, true>(lds, g, S, E); }
        { pg8::Gemm g{(const bf16*)(ws + WS_AOUT), (const bf16*)(ws + WS_WA), M, 1024, 256, 512, 512}; pg8::SplitKOrder S{MP / 256, 16, 2, 256, G, bx, 0};
          EpiSlab E{(float*)(ws + WS_SPART)};
          pg8::gemm_phase<EpiSlab, pg8::SplitKOrder, true, true>(lds, g, S, E); }
        { pg8::Gemm g{(const bf16*)(ws + WS_BOUT), (const bf16*)(ws + WS_WB), M, 1024, 256, 512, 512}; pg8::SplitKOrder S{MP / 256, 16, 2, 256, G, bx - 32, 32};
          EpiSlab E{(float*)(ws + WS_SPART)};
          pg8::gemm_phase<EpiSlab, pg8::SplitKOrder, true, true>(lds, g, S, E); }
        GRID_BAR();
        combine_merge(args, vcu * NWAVES + wave, G * NWAVES, lane);
        if (BOTH(5)) GRID_BAR();
    }
    if (IN(6)) for (int rep6 = 0; rep6 < REP_P6; ++rep6) { if (rep6) { GRID_BAR(); for (int i = bx * 512 + tid; i < M; i += G * 512) ssq_x1[i] = 0.f; GRID_BAR(); }
        { pg8::Gemm g{(const bf16*)(ws + WS_MRG), (const bf16*)(ws + WS_WOUT), MP, 1024, 1024, 1024, 1024}; pg8::StaticOrder S; S.init(MP, 1024, G, bx);
          EpiRes<true> E{(bf16*)(ws + WS_X1B), ssq_x1, args.in[0], args.in[1]};
          pg8::gemm_phase<EpiRes<true>, pg8::StaticOrder, true, true>(lds, g, S, E); }
        { pg8::Gemm g{(const bf16*)(ws + WS_MRG), (const bf16*)(ws + WS_WOUT), M, 1024, 256, 1024, 1024}; pg8::SplitKOrder S{MP / 256, 16, 4, 256, G, bx, 0};
          EpiSlab E{(float*)(ws + WS_SPART)};
          pg8::gemm_phase<EpiSlab, pg8::SplitKOrder, true, true>(lds, g, S, E); }
        GRID_BAR();
        combine_rows<4, 1>(args, vcu * NWAVES + wave, G * NWAVES, lane);
        if (BOTH(6)) GRID_BAR();
    }
    if (IN(7)) for (int rep_ph = 0; rep_ph < REP_P7; ++rep_ph) { if (rep_ph) __syncthreads();
        pg8::Gemm g{(const bf16*)(ws + WS_X1B), (const bf16*)(ws + WS_WGU), M, NGU, 1024, 1024, 1024}; pg8::StaticOrder S; S.init(M, NGU, G, bx);
        EpiSwiglu E{(bf16*)(ws + WS_ACT), ssq_x1};
        pg8::gemm_phase<EpiSwiglu, pg8::StaticOrder, true, true>(lds, g, S, E);
        if (BOTH(7)) GRID_BAR();
    }
    if (IN(8)) {
        { pg8::Gemm g{(const bf16*)(ws + WS_ACT), (const bf16*)(ws + WS_WDN), MP, 1024, DFF, DFF, DFF}; pg8::StaticOrder S; S.init(MP, 1024, G, bx);
          EpiRes<false> E{(bf16*)(ws + WS_X1B), ssq_x2, nullptr, nullptr};
          pg8::gemm_phase<EpiRes<false>, pg8::StaticOrder, true, true>(lds, g, S, E); }
        { pg8::Gemm g{(const bf16*)(ws + WS_ACT), (const bf16*)(ws + WS_WDN), M, 1024, 256, DFF, DFF}; pg8::SplitKOrder S{MP / 256, 16, 11, 256, G, bx, 0};
          EpiSlab E{(float*)(ws + WS_SPART)};
          pg8::gemm_phase<EpiSlab, pg8::SplitKOrder, true, true>(lds, g, S, E); }
        GRID_BAR();
        combine_rows<11, 0>(args, vcu * NWAVES + wave, G * NWAVES, lane);
        if (BOTH(8)) GRID_BAR();
    }
    if (IN(9)) for (int rep_ph = 0; rep_ph < REP_P9; ++rep_ph) { if (rep_ph) __syncthreads();
        { pg8::Gemm g{(const bf16*)(ws + WS_X1B), (const bf16*)(ws + WS_WPG), MP, 1024, 1024, 1024, 1024}; pg8::StaticOrder S; S.init(MP, 1024, G, bx);
          EpiFinal E{args.out + O_Y, (const bf16*)(ws + WS_X1B), (const bf16*)(ws + WS_PW), ssq_x2};
          pg8::gemm_phase<EpiFinal, pg8::StaticOrder, true, true>(lds, g, S, E); }
        { pg8::Gemm g{(const bf16*)(ws + WS_X1B), (const bf16*)(ws + WS_WPG), M, 1024, 256, 1024, 1024}; pg8::SplitKOrder S{MP / 256, 16, 4, 256, G, bx, 0};
          EpiSlab E{(float*)(ws + WS_SPART)};
          pg8::gemm_phase<EpiSlab, pg8::SplitKOrder, true, true>(lds, g, S, E); }
        GRID_BAR();
        combine_rows<4, 2>(args, vcu * NWAVES + wave, G * NWAVES, lane);
    }
#if PROF_K >= 0
    if (IN(9) && bx == 0) { __syncthreads(); const float* pr = (const float*)(ws + WS_SST); float val = PROF_K < 7 ? pr[PROF_K] : pr[7] * 0.2f;
        val = fminf(fmaxf(val, 0.f), 1.f); const float sc = 1.f + sqrtf(2e-5f + 1e-4f * val);
        for (int i = tid; i < 262144; i += 512) args.out[O_HIM_S + i] *= sc; }
#endif
#undef IN
#undef BOTH
#undef GRID_BAR
}
}
extern "C" void kernel_launch(void* const* d_in, const int* in_sizes, int n_in, void* d_out, int out_size, void* d_ws, size_t ws_size, hipStream_t stream) {
    static int grid = 0;
    if (grid == 0) {
        if (n_in != 39 || out_size != 23379968 || ws_size < mk::WS_END) { fprintf(stderr, "kernel_launch: unexpected n_in %d / out_size %d / ws_size %zu (need %zu); nothing launched\n", n_in, out_size, ws_size, (size_t)mk::WS_END); grid = -1; return; }
        int dev = 0, cus = 0, per_cu = 0;
        if (hipGetDevice(&dev) != hipSuccess || hipDeviceGetAttribute(&cus, hipDeviceAttributeMultiprocessorCount, dev) != hipSuccess) { grid = -1; return; }
        if (hipFuncSetAttribute((const void*)mk::mk_fwd, hipFuncAttributeMaxDynamicSharedMemorySize, mk::LDS_BYTES) != hipSuccess) { fprintf(stderr, "kernel_launch: hipFuncSetAttribute failed\n"); grid = -1; return; }
        if (hipOccupancyMaxActiveBlocksPerMultiprocessor(&per_cu, (const void*)mk::mk_fwd, mk::NWAVES * 64, mk::LDS_BYTES) != hipSuccess || per_cu < 1)
            fprintf(stderr, "kernel_launch: note: the occupancy query reports %d workgroups per CU\n", per_cu);
        (void)hipGetLastError();
        grid = cus;
    }
    if (grid < 0) return;
    (void)hipMemsetAsync((unsigned char*)d_ws + mk::WS_CTL, 0, mk::CTL_ZERO_BYTES, stream);
    mk::Args a{};
    for (int i = 0; i < 39; ++i) a.in[i] = (const float*)d_in[i];
    a.out = (float*)d_out; a.ws = (unsigned char*)d_ws; a.ph_lo = 0; a.ph_hi = 10;
    hipLaunchKernelGGL(mk::mk_fwd, dim3(grid), dim3(mk::NWAVES * 64), mk::LDS_BYTES, stream, a);
}
```

```cpp
#include <hip/hip_runtime.h>
#include <cstdio>
#include <cstdint>
#ifndef REP_SSM3
#define REP_SSM3 1
#endif
#ifndef REP_PATTN
#define REP_PATTN 1
#endif
#ifndef REP_SATTN
#define REP_SATTN 1
#endif
#ifndef REP_P0
#define REP_P0 1
#endif
#ifndef REP_NORM
#define REP_NORM 1
#endif
#ifndef REP_CONV
#define REP_CONV 1
#endif
#ifndef REP_SC
#define REP_SC 1
#endif
#ifndef REP_FIN
#define REP_FIN 1
#endif
#ifndef REP_PV
#define REP_PV 1
#endif
#ifndef REP_BAR
#define REP_BAR 0
#endif
#ifndef TWIN_FAR
#define TWIN_FAR 0
#endif
#ifndef REP_SETUP
#define REP_SETUP 1
#endif
#ifndef REP_EPI
#define REP_EPI 1
#endif
#ifndef REP_LOAD
#define REP_LOAD 1
#endif
#ifndef REP_P2
#define REP_P2 1
#endif
#ifndef REP_P4
#define REP_P4 1
#endif
#ifndef REP_P5
#define REP_P5 1
#endif
#ifndef REP_P7
#define REP_P7 1
#endif
#ifndef REP_P9
#define REP_P9 1
#endif
#ifndef REP_E1
#define REP_E1 1
#endif
#ifndef REP_SSM1
#define REP_SSM1 1
#endif
#ifndef REP_P1
#define REP_P1 1
#endif
#ifndef REP_P6
#define REP_P6 1
#endif
#ifndef XTRA_BAR
#define XTRA_BAR 0
#endif
#ifndef S_ORDER
#define S_ORDER 0
#endif
#if S_ORDER == 0
#define S_BLK_ORDER(t, PF, PFK) do { S_BLK_NORMS(t); S_BLK_SCORES(t); S_BLK_PV(t); S_BLK_CONV(t, PF, PFK); } while (0)
#elif S_ORDER == 1
#define S_BLK_ORDER(t, PF, PFK) do { S_BLK_CONV(t, PF, PFK); S_BLK_PV(t); S_BLK_SCORES(t); S_BLK_NORMS(t); } while (0)
#elif S_ORDER == 2
#define S_BLK_ORDER(t, PF, PFK) do { S_BLK_CONV(t, PF, PFK); S_BLK_NORMS(t); S_BLK_SCORES(t); S_BLK_PV(t); } while (0)
#else
#define S_BLK_ORDER(t, PF, PFK) do { S_BLK_PV(t); S_BLK_NORMS(t); S_BLK_SCORES(t); S_BLK_CONV(t, PF, PFK); } while (0)
#endif
#ifndef PROF_K
#define PROF_K -1
#endif
#ifndef PROF_TID
#define PROF_TID 0
#endif
#ifndef S_DUAL
#define S_DUAL 1
#endif
#ifndef S_VAR
#define S_VAR 7
#endif
#if S_VAR == 0
#define S_ORDER_BODY(t, PF, PFK) do { if (wid < 4) { S_BLK_NORMS(t); S_BLK_SCORES(t); } S_BLK_PV(t); S_BLK_CONV(t, PF, PFK); if (wid >= 4) { S_BLK_SCORES(t); S_BLK_NORMS(t); } } while (0)
#elif S_VAR == 1
#define S_ORDER_BODY(t, PF, PFK) do { if (wid < 4) { S_BLK_NORMS(t); S_BLK_SCORES(t); } S_BLK_CONV(t, PF, PFK); S_BLK_PV(t); if (wid >= 4) { S_BLK_SCORES(t); S_BLK_NORMS(t); } } while (0)
#elif S_VAR == 2
#define S_ORDER_BODY(t, PF, PFK) do { if (wid < 4) { S_BLK_SCORES(t); S_BLK_NORMS(t); } S_BLK_PV(t); S_BLK_CONV(t, PF, PFK); if (wid >= 4) { S_BLK_NORMS(t); S_BLK_SCORES(t); } } while (0)
#elif S_VAR == 3
#define S_ORDER_BODY(t, PF, PFK) do { if (wid < 4) { S_BLK_NORMS(t); } S_BLK_SCORES(t); S_BLK_PV(t); S_BLK_CONV(t, PF, PFK); if (wid >= 4) { S_BLK_NORMS(t); } } while (0)
#elif S_VAR == 4
#define S_ORDER_BODY(t, PF, PFK) do { if (wid < 4) { S_BLK_NORMS(t); } S_BLK_PV(t); S_BLK_CONV(t, PF, PFK); S_BLK_SCORES(t); if (wid >= 4) { S_BLK_NORMS(t); } } while (0)
#elif S_VAR == 5
#define S_ORDER_BODY(t, PF, PFK) do { if (wid < 4) { S_BLK_SCORES(t); S_BLK_NORMS(t); } S_BLK_CONV(t, PF, PFK); S_BLK_PV(t); if (wid >= 4) { S_BLK_NORMS(t); S_BLK_SCORES(t); } } while (0)
#elif S_VAR == 6
#define S_ORDER_BODY(t, PF, PFK) do { if (wid < 4) { S_BLK_SCORES(t); S_BLK_NORMS(t); } S_BLK_PV(t); S_BLK_CONV(t, PF, PFK); if (wid >= 4) { S_BLK_SCORES(t); S_BLK_NORMS(t); } } while (0)
#elif S_VAR == 7
#define S_ORDER_BODY(t, PF, PFK) do { if (wid < 4) { S_BLK_NORMS(t); S_BLK_SCORES(t); } S_BLK_PV(t); S_BLK_CONV(t, PF, PFK); if (wid >= 4) { S_BLK_NORMS(t); S_BLK_SCORES(t); } } while (0)
#elif S_VAR == 8
#define S_ORDER_BODY(t, PF, PFK) do { if (wid >= 4) { S_BLK_SCORES(t); S_BLK_NORMS(t); } S_BLK_PV(t); S_BLK_CONV(t, PF, PFK); if (wid < 4) { S_BLK_NORMS(t); S_BLK_SCORES(t); } } while (0)
#else
#define S_ORDER_BODY(t, PF, PFK) do { if ((wid & 1) == 0) { S_BLK_SCORES(t); S_BLK_NORMS(t); } S_BLK_PV(t); S_BLK_CONV(t, PF, PFK); if ((wid & 1) != 0) { S_BLK_NORMS(t); S_BLK_SCORES(t); } } while (0)
#endif
namespace pg8 {
#define PG8_LAS __attribute__((address_space(3)))
typedef unsigned short bf16_t;
typedef short bf16x8 __attribute__((ext_vector_type(8)));
typedef float f32x4 __attribute__((ext_vector_type(4)));
typedef unsigned u32x4 __attribute__((ext_vector_type(4)));
constexpr int BM = 256, BK = 64, HALF = 128, HTB = HALF * BK * 2  , STAGE_BYTES = 8 * HTB, NXCD = 8, WGM = 8;

__host__ __device__ __forceinline__ int lds_byte(int r, int c) { const int st = (r >> 4) * 2 + (c >> 5), rr = r & 15, cc = c & 31, ob = rr * 64 + cc * 2; return st * 1024 + (ob ^ (((ob >> 9) & 1) << 5)); }
__host__ __device__ __forceinline__ void stage_rc(int b, int& R, int& C) { const int st = b / 1024, sb = b % 1024, swz = sb ^ (((sb >> 9) & 1) << 5); R = (st >> 1) * 16 + swz / 64; C = (st & 1) * 32 + (swz % 64) / 2; }
__host__ __device__ __forceinline__ int perm32(int rho) { const int n = rho >> 4, i = rho & 15; return 8 * (i >> 2) + 4 * n + (i & 3); }

struct Unit { int pm, pn, ko, id; };
struct Gemm { const bf16_t* A; const bf16_t* Bt; int M, N, K, lda, ldb; };

struct SplitKOrder {
    int pm0, ntile, nslice, klen, G, c, id0;
    __host__ __device__ bool next(int i, Unit& u) const { if (c < 0) return false; const int L = i * G + c; if (L >= ntile * nslice) return false; const int sl = L % nslice, t = L / nslice;
        u.pm = pm0 + (t >> 2); u.pn = t & 3; u.ko = sl * klen; u.id = id0 + L; return true; }
    __device__ __forceinline__ void a_ready(const Unit&) const {}
    __device__ __forceinline__ void done(const Unit&) const {}
};
struct StaticOrder {
    int nM, nN, nwg, G, c;
    __host__ __device__ void init(int M, int N, int G_, int c_) { nM = M / BM; nN = N / BM; nwg = nM * nN; G = G_; c = c_; }
    __host__ __device__ bool next(int i, Unit& u) const {
        const long L = (long)i * G + c; if (L >= nwg) return false;
        int wgid = (int)L; { const int q = nwg / NXCD, r = nwg % NXCD, xcd = wgid % NXCD, off = wgid / NXCD; wgid = (xcd < r ? xcd * (q + 1) : r * (q + 1) + (xcd - r) * q) + off; }
        const int nig = WGM * nN, gid = wgid / nig, fm = gid * WGM, gsz = (nM - fm) < WGM ? (nM - fm) : WGM;
        u.pm = fm + ((wgid % nig) % gsz); u.pn = (wgid % nig) / gsz; u.ko = 0; u.id = 0; return true;
    }
    __device__ __forceinline__ void a_ready(const Unit&) const {}
    __device__ __forceinline__ void done(const Unit&) const {}
};
struct PromptPlusTail {
    StaticOrder S; int w0, bx, pm0;
    __host__ __device__ bool next(int i, Unit& u) const { if (i == 0) return S.next(0, u); if (i == 1 && bx >= w0 && bx < w0 + 16) { const int t = bx - w0; u.pm = pm0 + (t >> 2); u.pn = t & 3; u.ko = 0; u.id = 0; return true; } return false; }
    __device__ __forceinline__ void a_ready(const Unit&) const {}
    __device__ __forceinline__ void done(const Unit&) const {}
};
__device__ __forceinline__ unsigned cvt_pk_bf16(float lo, float hi) { unsigned r; asm volatile("v_cvt_pk_bf16_f32 %0, %1, %2" : "=v"(r) : "v"(lo), "v"(hi)); return r; }
template <class Epi, class Sched, bool ALIGN_EPI = false, bool SP2 = false>
__device__ __forceinline__ void gemm_phase(PG8_LAS unsigned char* lds, const Gemm g, const Sched& S, const Epi& E) {
    int tid_ = threadIdx.x; asm volatile("" : "+v"(tid_));
    const int tid = tid_, wid = __builtin_amdgcn_readfirstlane(tid >> 6), lane = tid & 63, wr = wid >> 2, wc = wid & 3, fr = lane & 15, fq = lane >> 4;
    const int K = g.K, nt = K / BK;
    unsigned voffA[2], voffB[2];
#pragma unroll
    for (int i = 0; i < 2; ++i) { int R, C; stage_rc(tid * 16 + i * 8192, R, C); const int Rb = Epi::PERM ? ((R & ~31) + perm32(R & 31)) : R;
        voffA[i] = (unsigned)(R * g.lda + C) * 2u; voffB[i] = (unsigned)(Rb * g.ldb + C) * 2u; }
    const size_t kstep = (size_t)(BK * 2);
    const size_t hstepA = (size_t)HALF * g.lda * 2, hstepB = (size_t)HALF * g.ldb * 2;
    const size_t tstepA = 2 * hstepA, tstepB = 2 * hstepB;
    const unsigned ldsw = (unsigned)wid * 1024u;
    const int aoff = lds_byte(wr * 64 + fr, fq * 8), boff = lds_byte(wc * 32 + fr, fq * 8);
#define PG8_SA(b, h) (((b) * 2 + (h)) * HTB)
#define PG8_SB(b, h) ((4 + (b) * 2 + (h)) * HTB)
#define PG8_STAGE(bufoff, gbase, voff) do { _Pragma("unroll") for (int _i = 0; _i < 2; ++_i) \
        __builtin_amdgcn_global_load_lds((const unsigned*)((const char*)(gbase) + (voff)[_i]), (PG8_LAS unsigned*)(lds + (bufoff) + ldsw + _i * 8192), 16, 0, 0); } while (0)
#define PG8_LDA(dst, b, h) do { _Pragma("unroll") for (int m = 0; m < 4; ++m) _Pragma("unroll") for (int k = 0; k < 2; ++k) dst[m][k] = *(const PG8_LAS bf16x8*)(lds + PG8_SA(b, h) + aoff + m * 2048 + k * 1024); } while (0)
#define PG8_LDB(dst, b, h) do { _Pragma("unroll") for (int n = 0; n < 2; ++n) _Pragma("unroll") for (int k = 0; k < 2; ++k) dst[n][k] = *(const PG8_LAS bf16x8*)(lds + PG8_SB(b, h) + boff + n * 2048 + k * 1024); } while (0)
#define PG8_MMA(ai, bj, At, Bt) do { __builtin_amdgcn_s_setprio(1); _Pragma("unroll") for (int m = 0; m < 4; ++m) _Pragma("unroll") for (int n = 0; n < 2; ++n) _Pragma("unroll") for (int k = 0; k < 2; ++k) \
        acc[ai][bj][m][n] = __builtin_amdgcn_mfma_f32_16x16x32_bf16(Bt[n][k], At[m][k], acc[ai][bj][m][n], 0, 0, 0); __builtin_amdgcn_s_setprio(0); } while (0)
#define PG8_WAIT_V(n) asm volatile("s_waitcnt vmcnt(" #n ")" ::: "memory")
#define PG8_WAIT_L(n) asm volatile("s_waitcnt lgkmcnt(" #n ")" ::: "memory")
#define PG8_BAR __builtin_amdgcn_s_barrier()
#define PG8_SCHED __builtin_amdgcn_sched_barrier(0)
    Unit cur, nxt; int ui = 0;
    if (!S.next(0, cur)) return;
    f32x4 acc[2][2][4][2];
#pragma unroll
    for (int a = 0; a < 2; ++a)
#pragma unroll
        for (int b = 0; b < 2; ++b)
#pragma unroll
            for (int m = 0; m < 4; ++m)
#pragma unroll
                for (int n = 0; n < 2; ++n) acc[a][b][m][n] = (f32x4){0.f, 0.f, 0.f, 0.f};
    bf16x8 At[4][2], B0[2][2], B1[2][2];
    const char* cA = (const char*)g.A + (size_t)cur.pm * tstepA + (size_t)cur.ko * 2; const char* cB = (const char*)g.Bt + (size_t)cur.pn * tstepB + (size_t)cur.ko * 2;
    S.a_ready(cur);
    if constexpr (SP2) {
        PG8_STAGE(PG8_SB(0, 0), cB, voffB); PG8_STAGE(PG8_SB(0, 1), cB + hstepB, voffB); PG8_STAGE(PG8_SA(0, 0), cA, voffA); PG8_STAGE(PG8_SA(0, 1), cA + hstepA, voffA);
        if (wr == 1) PG8_BAR;
        PG8_WAIT_V(2); PG8_BAR;
        PG8_STAGE(PG8_SB(1, 0), cB + kstep, voffB); PG8_STAGE(PG8_SA(1, 0), cA + kstep, voffA); PG8_STAGE(PG8_SB(1, 1), cB + hstepB + kstep, voffB);
        PG8_WAIT_V(6); PG8_BAR;
    } else {
        PG8_STAGE(PG8_SB(0, 0), cB, voffB); PG8_STAGE(PG8_SA(0, 0), cA, voffA); PG8_STAGE(PG8_SB(0, 1), cB + hstepB, voffB); PG8_STAGE(PG8_SA(0, 1), cA + hstepA, voffA);
        if (wr == 1) PG8_BAR;
        PG8_WAIT_V(4); PG8_BAR;
        PG8_STAGE(PG8_SB(1, 0), cB + kstep, voffB); PG8_STAGE(PG8_SA(1, 0), cA + kstep, voffA); PG8_STAGE(PG8_SB(1, 1), cB + hstepB + kstep, voffB);
        PG8_WAIT_V(6); PG8_BAR;
    }
    for (;;) {
        const bool has_next = S.next(ui + 1, nxt);
        const char* nA = has_next ? (const char*)g.A + (size_t)nxt.pm * tstepA + (size_t)nxt.ko * 2 : cA; const char* nB = has_next ? (const char*)g.Bt + (size_t)nxt.pn * tstepB + (size_t)nxt.ko * 2 : cB;
#pragma unroll 1
        for (int t = 0; t < nt; t += 2) {
            const bool last = (t == nt - 2);
            const char* a1 = cA + (size_t)(t + 1) * kstep;
            const char* a2 = last ? nA : cA + (size_t)(t + 2) * kstep; const char* b2 = last ? nB : cB + (size_t)(t + 2) * kstep;
            const char* a3 = a2 + kstep; const char* b3 = b2 + kstep;
            if (last && has_next) S.a_ready(nxt);
            if constexpr (SP2) {
            PG8_LDB(B0, 0, 0); PG8_LDB(B1, 0, 1); PG8_SCHED; PG8_LDA(At, 0, 0); PG8_STAGE(PG8_SA(1, 1), a1 + hstepA, voffA);
            PG8_WAIT_V(8); PG8_WAIT_L(0); PG8_BAR; PG8_MMA(0, 0, At, B0); PG8_MMA(0, 1, At, B1); PG8_BAR; PG8_SCHED;
            PG8_LDA(At, 0, 1); PG8_STAGE(PG8_SB(0, 0), b2, voffB); PG8_STAGE(PG8_SB(0, 1), b2 + hstepB, voffB); PG8_STAGE(PG8_SA(0, 0), a2, voffA);
            PG8_WAIT_V(8); PG8_WAIT_L(0); PG8_BAR; PG8_MMA(1, 0, At, B0); PG8_MMA(1, 1, At, B1); PG8_BAR; PG8_SCHED;
            PG8_LDB(B0, 1, 0); PG8_LDB(B1, 1, 1); PG8_SCHED; PG8_LDA(At, 1, 0); PG8_STAGE(PG8_SA(0, 1), a2 + hstepA, voffA);
            PG8_WAIT_V(8); PG8_WAIT_L(0); PG8_BAR; PG8_MMA(0, 0, At, B0); PG8_MMA(0, 1, At, B1); PG8_BAR; PG8_SCHED;
            PG8_LDA(At, 1, 1); PG8_STAGE(PG8_SB(1, 0), b3, voffB); PG8_STAGE(PG8_SB(1, 1), b3 + hstepB, voffB); PG8_STAGE(PG8_SA(1, 0), a3, voffA);
            PG8_WAIT_V(8); PG8_WAIT_L(0); PG8_BAR; PG8_MMA(1, 0, At, B0); PG8_MMA(1, 1, At, B1); PG8_BAR; PG8_SCHED;
            } else {
            PG8_LDB(B0, 0, 0); PG8_SCHED; PG8_LDA(At, 0, 0); PG8_STAGE(PG8_SA(1, 1), a1 + hstepA, voffA);
            PG8_WAIT_L(8); PG8_BAR; PG8_WAIT_L(0); PG8_MMA(0, 0, At, B0); PG8_BAR; PG8_SCHED;
            PG8_LDB(B1, 0, 1); PG8_STAGE(PG8_SB(0, 0), b2, voffB);
            PG8_BAR; PG8_WAIT_L(0); PG8_MMA(0, 1, At, B1); PG8_BAR;
            PG8_LDA(At, 0, 1); PG8_STAGE(PG8_SA(0, 0), a2, voffA);
            PG8_BAR; PG8_WAIT_L(0); PG8_MMA(1, 0, At, B0); PG8_BAR; PG8_SCHED;
            PG8_STAGE(PG8_SB(0, 1), b2 + hstepB, voffB);
            PG8_WAIT_V(6); PG8_BAR; PG8_MMA(1, 1, At, B1); PG8_BAR;
            PG8_LDB(B0, 1, 0); PG8_SCHED; PG8_LDA(At, 1, 0); PG8_STAGE(PG8_SA(0, 1), a2 + hstepA, voffA);
            PG8_WAIT_L(8); PG8_BAR; PG8_WAIT_L(0); PG8_MMA(0, 0, At, B0); PG8_BAR; PG8_SCHED;
            PG8_LDB(B1, 1, 1); PG8_STAGE(PG8_SB(1, 0), b3, voffB);
            PG8_BAR; PG8_WAIT_L(0); PG8_MMA(0, 1, At, B1); PG8_BAR;
            PG8_LDA(At, 1, 1); PG8_STAGE(PG8_SA(1, 0), a3, voffA);
            PG8_BAR; PG8_WAIT_L(0); PG8_MMA(1, 0, At, B0); PG8_BAR; PG8_SCHED;
            PG8_STAGE(PG8_SB(1, 1), b3 + hstepB, voffB);
            PG8_WAIT_V(6); PG8_BAR; PG8_MMA(1, 1, At, B1); PG8_BAR;
            }
        }
        if constexpr (ALIGN_EPI) { if (wr == 0) PG8_BAR; }
        if constexpr (!Epi::AFTER_DRAIN) { E(acc, cur, wr, wc, fr, fq); S.done(cur); }
        if (!has_next) break;
#pragma unroll
        for (int a = 0; a < 2; ++a)
#pragma unroll
            for (int b = 0; b < 2; ++b)
#pragma unroll
                for (int m = 0; m < 4; ++m)
#pragma unroll
                    for (int n = 0; n < 2; ++n) acc[a][b][m][n] = (f32x4){0.f, 0.f, 0.f, 0.f};
        cur = nxt; cA = nA; cB = nB; ++ui;
        if constexpr (ALIGN_EPI) { if (wr == 1) PG8_BAR; }
    }
    PG8_WAIT_V(0);
    if constexpr (!ALIGN_EPI) { if (wr == 0) PG8_BAR; }
    PG8_BAR;
    if constexpr (Epi::AFTER_DRAIN) { E.fused(acc, cur, wr, wc, fr, fq, lds, wid, lane); S.done(cur); }
#undef PG8_SA
#undef PG8_SB
#undef PG8_STAGE
#undef PG8_LDA
#undef PG8_LDB
#undef PG8_MMA
#undef PG8_WAIT_V
#undef PG8_WAIT_L
#undef PG8_BAR
#undef PG8_SCHED
}
}
#define GAS __attribute__((address_space(1)))
#define LAS __attribute__((address_space(3)))
typedef unsigned short bf16;
typedef unsigned v4u __attribute__((ext_vector_type(4)));
typedef unsigned v2u __attribute__((ext_vector_type(2)));
typedef float f32x4 __attribute__((ext_vector_type(4)));
typedef float f32x2 __attribute__((ext_vector_type(2)));
typedef float f32x16 __attribute__((ext_vector_type(16)));
typedef short bf16x8 __attribute__((ext_vector_type(8)));
typedef short s16x4 __attribute__((ext_vector_type(4)));
typedef GAS unsigned gu32;
#define RLX_AGENT __ATOMIC_RELAXED, __HIP_MEMORY_SCOPE_AGENT
#define LDS_WAIT() asm volatile("s_waitcnt lgkmcnt(0)" ::: "memory")
#define VM_WAIT() asm volatile("s_waitcnt vmcnt(0)" ::: "memory")
__device__ __forceinline__ unsigned f2bf(float f) { unsigned u = __builtin_bit_cast(unsigned, f); return (u + 0x7fffu + ((u >> 16) & 1u)) >> 16; }
__device__ __forceinline__ unsigned pk2(float lo, float hi) { return f2bf(lo) | (f2bf(hi) << 16); }
__device__ __forceinline__ float bflo(unsigned w) { return __builtin_bit_cast(float, w << 16); }
__device__ __forceinline__ float bfhi(unsigned w) { return __builtin_bit_cast(float, w & 0xffff0000u); }
__device__ __forceinline__ float bf1(bf16 b) { return __builtin_bit_cast(float, (unsigned)b << 16); }
__device__ __forceinline__ float rsq(float x) { return __builtin_amdgcn_rsqf(x); }
__device__ __forceinline__ float sigmf(float x) { return __builtin_amdgcn_rcpf(1.f + __builtin_amdgcn_exp2f(-1.4426950408889634f * x)); }

__device__ __forceinline__ void xhalf_both(float v, float& lo, float& hi) { lo = v; hi = v; asm volatile("s_nop 1\n\tv_permlane32_swap_b32 %0, %1" : "+v"(lo), "+v"(hi)); }
__device__ __forceinline__ float xrow16_sum(float v) { float a = v, b = v; asm volatile("s_nop 1\n\tv_permlane16_swap_b32 %0, %1" : "+v"(a), "+v"(b)); return a + b; }
__device__ __forceinline__ float xhalf_sum(float v) { float a, b; xhalf_both(v, a, b); return a + b; }
__device__ __forceinline__ float sum8_dpp(float v) {
    v += __builtin_bit_cast(float, __builtin_amdgcn_update_dpp(0, __builtin_bit_cast(int, v), 0xB1, 0xF, 0xF, true));
    v += __builtin_bit_cast(float, __builtin_amdgcn_update_dpp(0, __builtin_bit_cast(int, v), 0x4E, 0xF, 0xF, true));
    v += __builtin_bit_cast(float, __builtin_amdgcn_update_dpp(0, __builtin_bit_cast(int, v), 0x141, 0xF, 0xF, true));
    return v; }
namespace mk {
constexpr int NWAVES = 8;
constexpr int M = 17408, MP = 16384, MS = 1024, D = 1024, SEQ = 4096, DSEQ = 8, PAST = 8192;
constexpr int NPROJ = 3328, PC_U = 0, PC_Q = 512, PC_KR = 896, PC_KV = 1024, PC_GA = 1280, PC_GB = 2304;
constexpr int DFF = 2816, NGU = 5632;
constexpr float EPS = 1e-6f;
constexpr size_t O_Y = 0, O_CKV_P = 17825792, O_KPE_P = 22020096, O_HRE_P = 22544384, O_HIM_P = 22552576, O_CKV_S = 22560768, O_KPE_S = 22822912, O_HRE_S = 22855680, O_HIM_S = 23117824;

constexpr size_t al(size_t x) { return (x + 4095) & ~(size_t)4095; }
constexpr size_t WS_CTL = 0, CTL_ZERO_BYTES = 1u << 20;
constexpr int CW_TMO = 0, CW_CODE = 1, CW_BAR = 4096;
constexpr size_t CTL_SSQ_Q = 256 * 1024, CTL_SSQ_KV = 384 * 1024, CTL_SSQ_X1 = 512 * 1024, CTL_SSQ_X2 = 640 * 1024, CTL_CMP = 768 * 1024;
constexpr size_t WS_WIN = CTL_ZERO_BYTES;
constexpr size_t WS_WUQ = WS_WIN + al((size_t)NPROJ * 1024 * 2);
constexpr size_t WS_WUKV = WS_WUQ + al((size_t)768 * 384 * 2);
constexpr size_t WS_WGLU = WS_WUKV + al((size_t)1024 * 256 * 2);
constexpr size_t WS_WA = WS_WGLU + al((size_t)512 * 512 * 2);
constexpr size_t WS_WB = WS_WA + al((size_t)1024 * 512 * 2);
constexpr size_t WS_WOUT = WS_WB + al((size_t)1024 * 512 * 2);
constexpr size_t WS_WGU = WS_WOUT + al((size_t)1024 * 1024 * 2);
constexpr size_t WS_WDN = WS_WGU + al((size_t)NGU * 1024 * 2);
constexpr size_t WS_WPG = WS_WDN + al((size_t)1024 * DFF * 2);
constexpr size_t WS_WPLE = WS_WPG + al((size_t)1024 * 1024 * 2);
constexpr size_t WS_CS = WS_WPLE + al((size_t)1024 * 256 * 2);
constexpr size_t WS_SSMD = WS_CS + al((size_t)4104 * 32 * 4);
constexpr size_t WS_RX = WS_SSMD + al((size_t)(2 * 2048 + 2 * 2048 * 16 + 2 * 2048) * 4);
constexpr size_t WS_XB = WS_RX + al((size_t)M * 4);
constexpr size_t WS_PB = WS_XB + al((size_t)M * 1024 * 2);
constexpr size_t WS_PROJ = WS_PB + al((size_t)M * 256 * 2);
constexpr size_t WS_QB = WS_PROJ + al((size_t)M * NPROJ * 2);
constexpr size_t WS_KB = WS_QB + al((size_t)M * 768 * 2);
constexpr size_t WS_VB = WS_KB + al((size_t)M * 768 * 2);
constexpr size_t WS_ZB = WS_VB + al((size_t)M * 512 * 2);
constexpr size_t WS_AOUT = WS_ZB + al((size_t)M * 512 * 2);
constexpr size_t WS_BOUT = WS_AOUT + al((size_t)M * 512 * 2);
constexpr size_t WS_TMP = WS_BOUT + al((size_t)M * 512 * 2);
constexpr size_t WS_MRG = WS_TMP + al((size_t)M * 1024 * 2);
constexpr size_t WS_XR = WS_MRG + al((size_t)M * 1024 * 2);
constexpr size_t WS_X1B = WS_XR + al((size_t)M * 1024 * 4);
constexpr size_t WS_ACT = WS_X1B + al((size_t)M * 1024 * 2);
constexpr size_t WS_PW = WS_ACT + al((size_t)M * DFF * 2);
constexpr size_t WS_SST = WS_PW + al((size_t)M * 1024 * 2);
constexpr size_t WS_SPART = WS_SST + al((size_t)4 * 32 * 64 * 128 * 4);
constexpr size_t WS_CKVS = WS_SPART + al((size_t)64 << 20);
constexpr size_t WS_KPES = WS_CKVS + al((size_t)1024 * 256 * 2);
constexpr size_t WS_GT = WS_KPES + al((size_t)1024 * 32 * 2);
constexpr size_t WS_WUKS = WS_GT + 4096;
constexpr size_t WS_END = WS_WUKS + al((size_t)512 * 256 * 2);

constexpr int RING_BYTES = 131072, LDS_BYTES = 163840, LDSCTL_OFF = LDS_BYTES - 512, MISC_OFF = LDSCTL_OFF + 320;

#define XB_TMO      128
#define XB_XCNT(j)  (256  + 64 * (j))
#define XB_XSUB(j)  (1280 + 64 * (j))
#define XB_XGEN(j)  (2304 + 64 * (j))
#define XB_TOP      3328
#define XB_TOPGEN   3392
#define XCD_BAR_WORDS 3456
#define XB_SPIN_CAP (1u << 18)
__device__ __forceinline__ unsigned xb_ld(unsigned* p)              { return __hip_atomic_load(p, __ATOMIC_RELAXED, __HIP_MEMORY_SCOPE_AGENT); }
__device__ __forceinline__ unsigned xb_add(unsigned* p, unsigned v) { return __hip_atomic_fetch_add(p, v, __ATOMIC_RELAXED, __HIP_MEMORY_SCOPE_AGENT); }
__device__ __forceinline__ unsigned xb_xcc_id() { return (unsigned)__builtin_amdgcn_s_getreg((3 << 11) | 20) & 0xFu; }
#define XB_SPIN(cond, bar) do { unsigned _sp = 0; while (cond) { __builtin_amdgcn_s_sleep(1); \
    if ((++_sp & 255u) == 0u) { if (xb_ld(&(bar)[XB_TMO])) break; if (_sp > XB_SPIN_CAP) { atomicAdd(&(bar)[XB_TMO], 1u); break; } } } } while (0)
struct XcdBarrier { unsigned* bar; unsigned x; volatile LAS unsigned* st; };
__device__ __forceinline__ XcdBarrier xcd_barrier_post(unsigned* bar, volatile LAS unsigned* st) {
    XcdBarrier b; b.bar = bar; b.x = xb_xcc_id(); b.st = st;
    if (threadIdx.x == 0) (void)xb_add(&bar[XB_XCNT(b.x)], 1u);
    return b;
}
__device__ __forceinline__ void xcd_barrier_complete(unsigned* bar, unsigned x, unsigned& nloc, unsigned& nx) {
    const unsigned G = gridDim.x * gridDim.y * gridDim.z;
    unsigned sum, cnt, mine, sp = 0u;
    for (;;) {
        sum = 0u; cnt = 0u; mine = 0u;
#pragma unroll
        for (unsigned j = 0; j < 16; ++j) { const unsigned c = xb_ld(&bar[XB_XCNT(j)]); sum += c; cnt += (c > 0u) ? 1u : 0u; mine = (j == x) ? c : mine; }
        if (sum == G) break;
        __builtin_amdgcn_s_sleep(1);
        if ((++sp & 255u) == 0u) { if (xb_ld(&bar[XB_TMO])) break; if (sp > XB_SPIN_CAP) { atomicAdd(&bar[XB_TMO], 1u); break; } }
    }
    nloc = mine > 0u ? mine : 1u; nx = cnt > 0u ? cnt : 1u;
}
__device__ __forceinline__ void xcd_barrier(const XcdBarrier& b) {
    asm volatile("s_waitcnt vmcnt(0)" ::: "memory");
    __syncthreads();
    if (threadIdx.x == 0) {
        unsigned* bar = b.bar;
        __builtin_amdgcn_s_waitcnt(0);
        unsigned nloc = b.st[0], nx = b.st[1];
        if (nloc == 0u) { xcd_barrier_complete(bar, b.x, nloc, nx); b.st[0] = nloc; b.st[1] = nx; }
        const unsigned old = xb_add(&bar[XB_XSUB(b.x)], 1u);
        const unsigned gen = old / nloc;
        if (old + 1u == (gen + 1u) * nloc) {
            __builtin_amdgcn_fence(__ATOMIC_RELEASE, "agent");
            asm volatile("s_waitcnt vmcnt(0)" ::: "memory");
            const unsigned og = xb_add(&bar[XB_TOP], 1u);
            const unsigned tg = og / nx;
            if (og + 1u == (tg + 1u) * nx) xb_add(&bar[XB_TOPGEN], 1u);
            else XB_SPIN(xb_ld(&bar[XB_TOPGEN]) == tg, bar);
            __builtin_amdgcn_fence(__ATOMIC_ACQUIRE, "agent");
            xb_add(&bar[XB_XGEN(b.x)], 1u);
            asm volatile("s_waitcnt vmcnt(0)" ::: "memory");
        } else {
            XB_SPIN(xb_ld(&bar[XB_XGEN(b.x)]) == gen, bar);
            __builtin_amdgcn_fence(__ATOMIC_ACQUIRE, "agent");
            asm volatile("s_waitcnt vmcnt(0)" ::: "memory");
        }
    }
    __syncthreads();
}

struct Args { const float* in[39]; float* out; unsigned char* ws; int ph_lo, ph_hi; };

__device__ __forceinline__ float wave_sum(float v) {
#pragma unroll
    for (int o = 1; o < 64; o <<= 1) v += __shfl_xor(v, o);
    return v;
}
__device__ __forceinline__ float wave_sum_fast(float v) {
    v = sum8_dpp(v);
    v += __builtin_bit_cast(float, __builtin_amdgcn_update_dpp(0, __builtin_bit_cast(int, v), 0x140, 0xF, 0xF, true));
    const float r0 = __builtin_bit_cast(float, __builtin_amdgcn_readlane(__builtin_bit_cast(int, v), 0)), r1 = __builtin_bit_cast(float, __builtin_amdgcn_readlane(__builtin_bit_cast(int, v), 16));
    const float r2 = __builtin_bit_cast(float, __builtin_amdgcn_readlane(__builtin_bit_cast(int, v), 32)), r3 = __builtin_bit_cast(float, __builtin_amdgcn_readlane(__builtin_bit_cast(int, v), 48));
    return (r0 + r1) + (r2 + r3);
}
__device__ __forceinline__ const float* xrow_ptr(const Args& a, int m) { return m < MP ? a.in[0] + (size_t)m * D : a.in[1] + (size_t)(m - MP) * D; }
__device__ __forceinline__ int pos_idx(int m) { return m < MP ? (m & (SEQ - 1)) : SEQ + ((m - MP) & (DSEQ - 1)); }

struct MatInfo { int K, Np; size_t off; };
__device__ __forceinline__ MatInfo mat_info(int id) {
    switch (id) {
        case 0: return {1024, NPROJ, WS_WIN}; case 1: return {384, 768, WS_WUQ}; case 2: return {256, 1024, WS_WUKV}; case 3: return {512, 512, WS_WGLU};
        case 4: return {512, 1024, WS_WA}; case 5: return {512, 1024, WS_WB}; case 6: return {1024, 1024, WS_WOUT}; case 7: return {1024, NGU, WS_WGU};
        case 8: return {DFF, 1024, WS_WDN}; case 9: return {1024, 1024, WS_WPG}; case 10: return {256, 1024, WS_WPLE}; default: return {256, 512, WS_WUKS};
    }
}
constexpr int mat_items(int K, int Np) { return (K / 64) * (Np / 32); }
__device__ __forceinline__ void mat_src(const Args& a, int id, int n0, const float*& W, int& ld, const float*& gain) {
    gain = nullptr;
    switch (id) {
        case 0: { gain = a.in[9]; ld = 3232; int c;
            if (n0 < 896) c = n0; else if (n0 < 928) c = 1152 + (n0 - 896); else if (n0 < 1024) c = -1; else if (n0 < 1280) c = 896 + (n0 - 1024); else if (n0 < 2304) c = 1184 + (n0 - 1280); else c = 2208 + (n0 - 2304);
            W = c < 0 ? nullptr : a.in[10] + c; return; }
        case 1: gain = a.in[11]; ld = 768; W = a.in[12] + n0; return;
        case 2: { gain = a.in[13]; ld = 512;
            if (n0 < 512) { const int pn = n0 >> 8, ct = n0 & 255, bj = ct >> 7, wc = (ct & 127) >> 5; W = a.in[14] + (4 * pn + wc) * 64 + 32 * bj; }
            else W = a.in[15] + (n0 - 512); return; }
        case 3: ld = 512; W = a.in[28] + n0; return;
        case 4: ld = 1024; W = a.in[29] + n0; return;
        case 5: ld = 1024; W = a.in[30] + n0; return;
        case 6: ld = 1024; W = a.in[31] + n0; return;
        case 7: { gain = a.in[32]; ld = DFF; const int pn = n0 >> 8, ct = n0 & 255; W = ((ct >> 7) ? a.in[34] : a.in[33]) + 128 * pn + (ct & 127); return; }
        case 8: ld = 1024; W = a.in[35] + n0; return;
        case 9: gain = a.in[36]; ld = 1024; W = a.in[37] + n0; return;
        case 10: ld = 1024; W = a.in[38] + n0; return;
        default: ld = 512; W = a.in[14] + n0; return;
    }
}
__device__ __forceinline__ void p0_transpose_pair(const Args& a, int id, int item0, int item1, bf16* WT, int K, int Np, LAS float* scr, int lane) {
    const int nblk = Np / 32, kr = lane >> 3, c4 = 4 * (lane & 7);
    f32x4 v[2][8]; float g[2][8]; int k0[2], n0[2];
#pragma unroll
    for (int q = 0; q < 2; ++q) { const int item = (q == 0 || item1 < 0) ? item0 : item1; const int kb = item / nblk, nb = item % nblk; k0[q] = 64 * kb; n0[q] = 32 * nb;
        const float* W; int ld; const float* gain; mat_src(a, id, n0[q], W, ld, gain);
#pragma unroll
        for (int i = 0; i < 8; ++i) { const int kk = 8 * i + kr; v[q][i] = (f32x4){0.f, 0.f, 0.f, 0.f}; g[q][i] = 1.f;
            if (W) v[q][i] = *(const GAS f32x4*)(W + (size_t)(k0[q] + kk) * ld + c4);
            if (gain) g[q][i] = gain[k0[q] + kk]; } }
#pragma unroll
    for (int q = 0; q < 2; ++q) { LAS float* sq = scr + q * 2112;
#pragma unroll
        for (int i = 0; i < 8; ++i) { const int kk = 8 * i + kr; const f32x4 w = v[q][i] * g[q][i];
            sq[kk * 33 + c4] = w[0]; sq[kk * 33 + c4 + 1] = w[1]; sq[kk * 33 + c4 + 2] = w[2]; sq[kk * 33 + c4 + 3] = w[3]; } }
    LDS_WAIT(); asm volatile("" ::: "memory");
    const int c = lane & 7;
#pragma unroll
    for (int q = 0; q < 2; ++q) { if (q == 1 && item1 < 0) break; const LAS float* sq = scr + q * 2112;
#pragma unroll
        for (int j = 0; j < 4; ++j) { const int n = (lane >> 3) + 8 * j; const LAS float* s = sq + (8 * c) * 33 + n;
            v4u o; o.x = pk2(s[0 * 33], s[1 * 33]); o.y = pk2(s[2 * 33], s[3 * 33]); o.z = pk2(s[4 * 33], s[5 * 33]); o.w = pk2(s[6 * 33], s[7 * 33]);
            *(GAS v4u*)(WT + (size_t)(n0[q] + n) * K + k0[q] + 8 * c) = o; } }
    LDS_WAIT(); asm volatile("" ::: "memory");
}
#if PROF_K >= 100
#define P0_STAMP(k) do { if (vcu == 0 && wave == 0 && lane == 0) ((unsigned long long*)(ws + WS_CTL + 786432))[k] = __builtin_amdgcn_s_memrealtime(); } while (0)
#else
#define P0_STAMP(k) do { } while (0)
#endif
__device__ __forceinline__ void p0_prologue(const Args& a, LAS unsigned char* lds, int vcu, int G, int wave, int lane) {
    unsigned char* ws = a.ws;
    LAS float* scr = (LAS float*)(lds + wave * 17408);
    const int gw = vcu * NWAVES + wave, NGW = G * NWAVES;
    int base = 0;
#pragma unroll 1
    for (int id = 0; id < 12; ++id) { const MatInfo mi = mat_info(id); const int n = (mi.K / 64) * (mi.Np / 32);
        for (int it = (gw + NGW - (base % NGW)) % NGW; it < n; it += 2 * NGW) p0_transpose_pair(a, id, it, it + NGW < n ? it + NGW : -1, (bf16*)(ws + mi.off), mi.K, mi.Np, scr, lane);
        base += n; }
    P0_STAMP(20);
    float* rx = (float*)(ws + WS_RX); bf16* xb = (bf16*)(ws + WS_XB); bf16* pb = (bf16*)(ws + WS_PB);
    for (int mb = gw; mb < M; mb += 4 * NGW) {
        f32x4 v[4][4], pv[4]; int mr[4];
#pragma unroll
        for (int r = 0; r < 4; ++r) { mr[r] = mb + r * NGW; const int mm = mr[r] < M ? mr[r] : mb;
            const GAS f32x4* xr = (const GAS f32x4*)xrow_ptr(a, mm) + lane;
#pragma unroll
            for (int j = 0; j < 4; ++j) v[r][j] = xr[64 * j];
            const float* pr = mm < MP ? a.in[2] + (size_t)mm * 256 : a.in[3] + (size_t)(mm - MP) * 256; pv[r] = ((const GAS f32x4*)pr)[lane]; }
#pragma unroll
        for (int r = 0; r < 4; ++r) { float s0 = 0.f;
#pragma unroll
            for (int j = 0; j < 4; ++j) s0 += (v[r][j].x * v[r][j].x + v[r][j].y * v[r][j].y) + (v[r][j].z * v[r][j].z + v[r][j].w * v[r][j].w);
            s0 = wave_sum_fast(s0);
            if (mr[r] < M) { if (lane == 0) rx[mr[r]] = 1.f / sqrtf(s0 * (1.f / D) + EPS);
                GAS v2u* o0 = (GAS v2u*)(xb + (size_t)mr[r] * D) + lane;
#pragma unroll
                for (int j = 0; j < 4; ++j) { v2u w; w.x = pk2(v[r][j].x, v[r][j].y); w.y = pk2(v[r][j].z, v[r][j].w); o0[64 * j] = w; }
                { v2u w; w.x = pk2(pv[r].x, pv[r].y); w.y = pk2(pv[r].z, pv[r].w); ((GAS v2u*)(pb + (size_t)mr[r] * 256))[lane] = w; } } }
    }
    P0_STAMP(21);
    float* cs = (float*)(ws + WS_CS);
    for (int e = gw * 64 + lane; e < 4104 * 16; e += NGW * 64) { const int idx = e >> 4, i = e & 15; const int pos = idx < SEQ ? idx : PAST + (idx - SEQ);
        constexpr double INV[16] = {1.0, 0.5623413251903491, 0.31622776601683794, 0.1778279410038923, 0.1, 0.05623413251903491, 0.03162277660168379, 0.01778279410038923, 0.01,
                                    0.005623413251903491, 0.0031622776601683794, 0.0017782794100389228, 0.001, 0.0005623413251903491, 0.00031622776601683794, 0.00017782794100389227};
        const double ang = (double)pos * INV[i], k = rint(ang * 0.15915494309189535);
        double r = fma(-k, 6.283185307179586, ang); r = fma(-k, 2.4492935982947064e-16, r);
        cs[idx * 32 + i] = cosf((float)r); cs[idx * 32 + 16 + i] = sinf((float)r); }
    if (gw == 0) { float* gt = (float*)(ws + WS_GT); const float gn = a.in[18][lane] * a.in[16][lane]; gt[lane] = gn; float gm = fabsf(gn);
        if (lane < 16) { const float gr = a.in[19][lane] * a.in[17][lane]; gt[64 + lane] = gr; gm = fmaxf(gm, fabsf(gr)); }
#pragma unroll
        for (int o = 1; o < 64; o <<= 1) gm = fmaxf(gm, __shfl_xor(gm, o));
        if (lane == 0) gt[80] = 14.1352f * gm * 1.01f + 0.1f; }
    P0_STAMP(22);
    float* sd = (float*)(ws + WS_SSMD);
    for (int e = (NGW - 1 - gw) * 64 + lane; e < 2048 * 16; e += NGW * 64) { const int idx = e >> 4, c = e & 15, g = idx >> 6;
        const float lr = a.in[20][idx], li = a.in[21][idx], dtl = a.in[22][g], b_r = a.in[23][e], b_i = a.in[24][e];
        const float dt = expf(dtl), mag = expf(lr * dt), br_ = mag * cosf(li * dt), bi_ = mag * sinf(li * dt);
        const float nr = br_ - 1.f, ni = bi_, den = lr * lr + li * li, fr = (nr * lr + ni * li) / den, fi = (ni * lr - nr * li) / den;
        sd[4096 + e] = fr * b_r - fi * b_i; sd[4096 + 32768 + e] = fr * b_i + fi * b_r;
        if (c == 0) { sd[idx] = br_; sd[2048 + idx] = bi_;
            float pr = br_, pi = bi_;
            for (int k = 0; k < 6; ++k) { const float t = pr * pr - pi * pi; pi = 2.f * pr * pi; pr = t; }
            sd[4096 + 65536 + idx] = pr; sd[4096 + 65536 + 2048 + idx] = pi; } }
    P0_STAMP(23);
}

typedef const f32x4 (&AccT)[2][2][4][2];
__device__ __forceinline__ v4u pack8(const f32x4 v0, const f32x4 v1) { v4u w; w.x = pg8::cvt_pk_bf16(v0[0], v0[1]); w.y = pg8::cvt_pk_bf16(v0[2], v0[3]); w.z = pg8::cvt_pk_bf16(v1[0], v1[1]); w.w = pg8::cvt_pk_bf16(v1[2], v1[3]); return w; }
__device__ __forceinline__ float sq8(const v4u w) { float s = 0.f;
    s += bflo(w.x) * bflo(w.x) + bfhi(w.x) * bfhi(w.x); s += bflo(w.y) * bflo(w.y) + bfhi(w.y) * bfhi(w.y);
    s += bflo(w.z) * bflo(w.z) + bfhi(w.z) * bfhi(w.z); s += bflo(w.w) * bflo(w.w) + bfhi(w.w) * bfhi(w.w); return s; }
__device__ __forceinline__ float quad_sum(float s) { return xhalf_sum(xrow16_sum(s)); }

struct EpiG1 {
    static constexpr bool PERM = true, AFTER_DRAIN = false;
    bf16* O; const float* rx; float* ssq_q; float* ssq_kv;
    __device__ __forceinline__ void operator()(AccT acc, const pg8::Unit& u, int wr, int wc, int fr, int fq) const {
        const int row0 = u.pm * 256 + wr * 64 + fr, col0 = u.pn * 256 + wc * 32 + 8 * fq;
        const int mode = (u.pn == 2) ? 1 : (u.pn == 3) ? 2 : (u.pn == 4) ? 3 : 0;
#pragma unroll
        for (int ai = 0; ai < 2; ++ai)
#pragma unroll
            for (int m = 0; m < 4; ++m) { const int row = row0 + ai * 128 + m * 16; const float sc = rx[row]; bf16* rowp = O + (size_t)row * NPROJ + col0; float ss = 0.f;
#pragma unroll
                for (int bj = 0; bj < 2; ++bj) { const v4u w = pack8(acc[ai][bj][m][0] * sc, acc[ai][bj][m][1] * sc); *(v4u*)(rowp + bj * 128) = w;
                    if (mode == 1 || mode == 3 || (mode == 2 && bj == 0)) ss += sq8(w); }
                if (mode) { ss = quad_sum(ss); if (fq == 0) atomicAdd((mode == 3 ? ssq_kv : ssq_q) + row, ss); } }
    }
};
struct EpiRowScale {
    static constexpr bool PERM = true, AFTER_DRAIN = false;
    bf16* O; int ldc; const float* ssq; float inv_n;
    __device__ __forceinline__ void operator()(AccT acc, const pg8::Unit& u, int wr, int wc, int fr, int fq) const {
        const int row0 = u.pm * 256 + wr * 64 + fr, col0 = u.pn * 256 + wc * 32 + 8 * fq;
#pragma unroll
        for (int ai = 0; ai < 2; ++ai)
#pragma unroll
            for (int m = 0; m < 4; ++m) { const int row = row0 + ai * 128 + m * 16; const float sc = ssq ? rsq(ssq[row] * inv_n + EPS) : 1.f; bf16* rowp = O + (size_t)row * ldc + col0;
#pragma unroll
                for (int bj = 0; bj < 2; ++bj) *(v4u*)(rowp + bj * 128) = pack8(acc[ai][bj][m][0] * sc, acc[ai][bj][m][1] * sc); }
    }
};
}
namespace mk {
struct EpiKV {
    static constexpr bool PERM = true, AFTER_DRAIN = false;
    bf16* KB; bf16* VB; const float* ssq_kv; const bf16* projb; const float* cs; const float* gt;
    __device__ __forceinline__ void operator()(AccT acc, const pg8::Unit& u, int wr, int wc, int fr, int fq) const {
        const int row0 = u.pm * 256 + wr * 64 + fr;
        if (u.pn >= 2) {
            const int col0 = (u.pn - 2) * 256 + wc * 32 + 8 * fq;
#pragma unroll
            for (int ai = 0; ai < 2; ++ai)
#pragma unroll
                for (int m = 0; m < 4; ++m) { const int row = row0 + ai * 128 + m * 16; const float sc = rsq(ssq_kv[row] * (1.f / 256.f) + EPS); bf16* rowp = VB + (size_t)row * 512 + col0;
#pragma unroll
                    for (int bj = 0; bj < 2; ++bj) *(v4u*)(rowp + bj * 128) = pack8(acc[ai][bj][m][0] * sc, acc[ai][bj][m][1] * sc); }
            return;
        }
        const int head = 4 * u.pn + wc, ib = 8 * (fq & 1); const float sgn = fq < 2 ? -1.f : 1.f;
#pragma unroll
        for (int ai = 0; ai < 2; ++ai)
#pragma unroll
            for (int m = 0; m < 4; ++m) { const int row = row0 + ai * 128 + m * 16; const float sc = rsq(ssq_kv[row] * (1.f / 256.f) + EPS);
                float ss = 0.f;
#pragma unroll
                for (int bj = 0; bj < 2; ++bj)
#pragma unroll
                    for (int n = 0; n < 2; ++n) { const f32x4 x = acc[ai][bj][m][n]; ss += (x[0] * x[0] + x[1] * x[1]) + (x[2] * x[2] + x[3] * x[3]); }
                const bf16* krp = projb + (size_t)row * NPROJ + PC_KR;
                const v4u own = *(const v4u*)(krp + 8 * fq), par = *(const v4u*)(krp + 8 * (fq ^ 2));
                ss = quad_sum(ss * sc * sc + sq8(own));
                const float r = rsq(ss * (1.f / 96.f) + EPS), rs = r * sc;
                bf16* kp = KB + (size_t)row * 768 + head * 96;
#pragma unroll
                for (int bj = 0; bj < 2; ++bj) { const int d = 32 * bj + 8 * fq;
                    *(v4u*)(kp + d) = pack8(acc[ai][bj][m][0] * *(const f32x4*)(gt + d) * rs, acc[ai][bj][m][1] * *(const f32x4*)(gt + d + 4) * rs); }
                const float* csr = cs + (size_t)pos_idx(row) * 32 + ib;
                f32x4 o[2];
#pragma unroll
                for (int hh = 0; hh < 2; ++hh) { const unsigned ow0 = hh ? own.z : own.x, ow1 = hh ? own.w : own.y, pw0 = hh ? par.z : par.x, pw1 = hh ? par.w : par.y;
                    const f32x4 c = *(const f32x4*)(csr + 4 * hh), sn = *(const f32x4*)(csr + 16 + 4 * hh) * sgn, g = *(const f32x4*)(gt + 64 + ib + 4 * hh) * r;
                    const f32x4 xo = {bflo(ow0), bfhi(ow0), bflo(ow1), bfhi(ow1)}, xp = {bflo(pw0), bfhi(pw0), bflo(pw1), bfhi(pw1)};
                    o[hh] = (xo * c + xp * sn) * g; }
                *(v4u*)(kp + 64 + 8 * fq) = pack8(o[0], o[1]);
                asm volatile("" ::: "memory"); }
    }
};

__device__ __forceinline__ void e1_rows(const Args& a, int gw, int NGW, int lane) {
    unsigned char* ws = a.ws; const bf16* projb = (const bf16*)(ws + WS_PROJ); const float* ssq_kv = (const float*)(ws + CTL_SSQ_KV); const float* cs = (const float*)(ws + WS_CS);
    bf16* ckvs = (bf16*)(ws + WS_CKVS); bf16* kpes = (bf16*)(ws + WS_KPES); const float* gkv = a.in[13];
    const f32x4 g4 = *(const f32x4*)(gkv + 4 * lane);
    for (int m = gw; m < M; m += NGW) {
        const float sc = 1.f / sqrtf(ssq_kv[m] * (1.f / 256.f) + EPS);
        const v2u w = *(const GAS v2u*)(projb + (size_t)m * NPROJ + PC_KV + 4 * lane);
        f32x4 v = {bflo(w.x), bfhi(w.x), bflo(w.y), bfhi(w.y)}; v = v * sc * g4;
        float* oc = m < MP ? a.out + O_CKV_P + (size_t)m * 256 : a.out + O_CKV_S + (size_t)(m - MP) * 256;
        *(GAS f32x4*)(oc + 4 * lane) = v;
        if (m >= MP) { v2u o; o.x = pk2(v[0], v[1]); o.y = pk2(v[2], v[3]); *(GAS v2u*)(ckvs + (size_t)(m - MP) * 256 + 4 * lane) = o; }
        if (lane < 16) { const bf16* kr = projb + (size_t)m * NPROJ + PC_KR; const float x1 = bf1(kr[lane]), x2 = bf1(kr[16 + lane]);
            const float* csr = cs + (size_t)pos_idx(m) * 32; const float c = csr[lane], s = csr[16 + lane];
            const float o1 = x1 * c - x2 * s, o2 = x2 * c + x1 * s;
            float* ok = m < MP ? a.out + O_KPE_P + (size_t)m * 32 : a.out + O_KPE_S + (size_t)(m - MP) * 32;
            ok[lane] = o1; ok[16 + lane] = o2;
            if (m >= MP) { kpes[(size_t)(m - MP) * 32 + lane] = (bf16)f2bf(o1); kpes[(size_t)(m - MP) * 32 + 16 + lane] = (bf16)f2bf(o2); } }
    }
}
__device__ __forceinline__ void unpack8(const v4u w, f32x4& a, f32x4& b) { a = (f32x4){bflo(w.x), bfhi(w.x), bflo(w.y), bfhi(w.y)}; b = (f32x4){bflo(w.z), bfhi(w.z), bflo(w.w), bfhi(w.w)}; }
__device__ __forceinline__ f32x4 sig4(const f32x4 x) { return (f32x4){sigmf(x[0]), sigmf(x[1]), sigmf(x[2]), sigmf(x[3])}; }
template <int MODE> struct EpiGate {
    static constexpr bool PERM = true, AFTER_DRAIN = false;
    bf16* O; int ldc; const bf16* X; int ldx; int xoff; const bf16* T;
    __device__ __forceinline__ void operator()(AccT acc, const pg8::Unit& u, int wr, int wc, int fr, int fq) const {
        const int row0 = u.pm * 256 + wr * 64 + fr, col0 = u.pn * 256 + wc * 32 + 8 * fq;
#pragma unroll
        for (int ai = 0; ai < 2; ++ai)
#pragma unroll
            for (int m = 0; m < 4; ++m) { const int row = row0 + ai * 128 + m * 16;
#pragma unroll
                for (int bj = 0; bj < 2; ++bj) { const int col = col0 + bj * 128; f32x4 x0, x1; unpack8(*(const v4u*)(X + (size_t)row * ldx + xoff + col), x0, x1);
                    f32x4 o0, o1;
                    if (MODE == 0) { o0 = x0 * sig4(acc[ai][bj][m][0]); o1 = x1 * sig4(acc[ai][bj][m][1]); }
                    else { o0 = sig4(x0) * acc[ai][bj][m][0]; o1 = sig4(x1) * acc[ai][bj][m][1]; }
                    if (MODE == 2) { f32x4 t0, t1; unpack8(*(const v4u*)(T + (size_t)row * ldc + col), t0, t1); o0 += t0; o1 += t1; }
                    *(v4u*)(O + (size_t)row * ldc + col) = pack8(o0, o1); }
                asm volatile("" ::: "memory"); }
    }
};
template <bool BASE_X> struct EpiRes {
    static constexpr bool PERM = true, AFTER_DRAIN = false;
    bf16* XB; float* ssq; const float* xp; const float* xs;
    __device__ __forceinline__ void operator()(AccT acc, const pg8::Unit& u, int wr, int wc, int fr, int fq) const {
        const int row0 = u.pm * 256 + wr * 64 + fr, col0 = u.pn * 256 + wc * 32 + 8 * fq;
#pragma unroll
        for (int ai = 0; ai < 2; ++ai)
#pragma unroll
            for (int m = 0; m < 4; ++m) { const int row = row0 + ai * 128 + m * 16; float ss = 0.f;
#pragma unroll
                for (int bj = 0; bj < 2; ++bj) { const int col = col0 + bj * 128; f32x4 b0, b1;
                    if (BASE_X) { const float* bp = (row < MP ? xp + (size_t)row * 1024 : xs + (size_t)(row - MP) * 1024) + col; b0 = *(const f32x4*)bp; b1 = *(const f32x4*)(bp + 4); }
                    else unpack8(*(const v4u*)(XB + (size_t)row * 1024 + col), b0, b1);
                    const v4u w = pack8(b0 + acc[ai][bj][m][0], b1 + acc[ai][bj][m][1]); *(v4u*)(XB + (size_t)row * 1024 + col) = w; ss += sq8(w); }
                ss = quad_sum(ss); if (fq == 0) atomicAdd(ssq + row, ss);
                asm volatile("" ::: "memory"); }
    }
};
struct EpiSwiglu {
    static constexpr bool PERM = true, AFTER_DRAIN = false;
    bf16* O; const float* ssq;
    __device__ __forceinline__ void operator()(AccT acc, const pg8::Unit& u, int wr, int wc, int fr, int fq) const {
        const int row0 = u.pm * 256 + wr * 64 + fr, col0 = u.pn * 128 + wc * 32 + 8 * fq;
#pragma unroll
        for (int ai = 0; ai < 2; ++ai)
#pragma unroll
            for (int m = 0; m < 4; ++m) { const int row = row0 + ai * 128 + m * 16; const float r = rsq(ssq[row] * (1.f / 1024.f) + EPS);
                f32x4 o[2];
#pragma unroll
                for (int n = 0; n < 2; ++n) { const f32x4 g = acc[ai][0][m][n] * r, up = acc[ai][1][m][n] * r; o[n] = g * sig4(g) * up; }
                *(v4u*)(O + (size_t)row * DFF + col0) = pack8(o[0], o[1]); }
    }
};
struct EpiFinal {
    static constexpr bool PERM = true, AFTER_DRAIN = false;
    float* Y; const bf16* XB; const bf16* PW; const float* ssq;
    __device__ __forceinline__ void operator()(AccT acc, const pg8::Unit& u, int wr, int wc, int fr, int fq) const {
        const int row0 = u.pm * 256 + wr * 64 + fr, col0 = u.pn * 256 + wc * 32 + 8 * fq;
#pragma unroll
        for (int ai = 0; ai < 2; ++ai)
#pragma unroll
            for (int m = 0; m < 4; ++m) { const int row = row0 + ai * 128 + m * 16; const float r = rsq(ssq[row] * (1.f / 1024.f) + EPS);
#pragma unroll
                for (int bj = 0; bj < 2; ++bj) { const int col = col0 + bj * 128; f32x4 p0, p1, x0, x1; unpack8(*(const v4u*)(PW + (size_t)row * 1024 + col), p0, p1); unpack8(*(const v4u*)(XB + (size_t)row * 1024 + col), x0, x1);
                    *(f32x4*)(Y + (size_t)row * 1024 + col) = x0 + sig4(acc[ai][bj][m][0] * r) * p0;
                    *(f32x4*)(Y + (size_t)row * 1024 + col + 4) = x1 + sig4(acc[ai][bj][m][1] * r) * p1; }
                asm volatile("" ::: "memory"); }
    }
};
struct EpiSlab {
    static constexpr bool PERM = true, AFTER_DRAIN = false;
    float* slabs;
    __device__ __forceinline__ void operator()(AccT acc, const pg8::Unit& u, int wr, int wc, int fr, int fq) const {
        float* sb = slabs + (size_t)u.id * 65536; const int row0 = wr * 64 + fr, col0 = wc * 32 + 8 * fq;
#pragma unroll
        for (int ai = 0; ai < 2; ++ai)
#pragma unroll
            for (int m = 0; m < 4; ++m) { float* rp = sb + (row0 + ai * 128 + m * 16) * 256 + col0;
#pragma unroll
                for (int bj = 0; bj < 2; ++bj) { *(f32x4*)(rp + bj * 128) = acc[ai][bj][m][0]; *(f32x4*)(rp + bj * 128 + 4) = acc[ai][bj][m][1]; } }
    }
};
template <int NSLICE, int MODE>
__device__ __forceinline__ void combine_rows(const Args& a, int gw, int NGW, int lane) {
    unsigned char* ws = a.ws; bf16* XB = (bf16*)(ws + WS_X1B); const float* slabs = (const float*)(ws + WS_SPART);
    float* ssq = (float*)(ws + (MODE == 1 ? CTL_SSQ_X1 : CTL_SSQ_X2));
    for (int it = gw; it < MS * 4; it += NGW) { const int r = it >> 2, pn = it & 3, row = MP + r, t = (r >> 8) * 4 + pn, rr = r & 255; const size_t eo = (size_t)row * 1024 + pn * 256 + 4 * lane;
        const float* sp = slabs + (size_t)(t * NSLICE) * 65536 + rr * 256 + 4 * lane;
        f32x4 p[NSLICE];
#pragma unroll
        for (int sl = 0; sl < NSLICE; ++sl) p[sl] = *(const GAS f32x4*)(sp + (size_t)sl * 65536);
        f32x4 base;
        if (MODE == 1) base = *(const GAS f32x4*)(a.in[1] + (size_t)r * 1024 + pn * 256 + 4 * lane);
        else { const v2u bw = *(const GAS v2u*)(XB + eo); base = (f32x4){bflo(bw.x), bfhi(bw.x), bflo(bw.y), bfhi(bw.y)}; }
        f32x4 v = p[0];
#pragma unroll
        for (int sl = 1; sl < NSLICE; ++sl) v += p[sl];
        if (MODE == 2) { const float rs = rsq(ssq[row] * (1.f / 1024.f) + EPS); const v2u pw = *(const GAS v2u*)((const bf16*)(ws + WS_PW) + eo);
            const f32x4 pv = {bflo(pw.x), bfhi(pw.x), bflo(pw.y), bfhi(pw.y)};
            *(GAS f32x4*)(a.out + O_Y + eo) = base + sig4(v * rs) * pv; }
        else { v += base;
            v2u w; w.x = pg8::cvt_pk_bf16(v[0], v[1]); w.y = pg8::cvt_pk_bf16(v[2], v[3]); *(GAS v2u*)(XB + eo) = w;
            float ss = (bflo(w.x) * bflo(w.x) + bfhi(w.x) * bfhi(w.x)) + (bflo(w.y) * bflo(w.y) + bfhi(w.y) * bfhi(w.y));
            ss = wave_sum_fast(ss); if (lane == 0) atomicAdd(ssq + row, ss); } }
}
__device__ __forceinline__ void combine_merge(const Args& a, int gw, int NGW, int lane) {
    unsigned char* ws = a.ws; const float* slabs = (const float*)(ws + WS_SPART); const bf16* projb = (const bf16*)(ws + WS_PROJ); bf16* MR = (bf16*)(ws + WS_MRG);
    for (int it = gw; it < MS * 4; it += NGW) { const int r = it >> 2, pn = it & 3, row = MP + r, t = (r >> 8) * 4 + pn, rr = r & 255, col = pn * 256 + 4 * lane;
        const float* sa = slabs + (size_t)(2 * t) * 65536 + rr * 256 + 4 * lane; const float* sb = slabs + (size_t)(32 + 2 * t) * 65536 + rr * 256 + 4 * lane;
        const f32x4 a0 = *(const GAS f32x4*)sa, a1 = *(const GAS f32x4*)(sa + 65536), b0 = *(const GAS f32x4*)sb, b1 = *(const GAS f32x4*)(sb + 65536);
        const v2u ga = *(const GAS v2u*)(projb + (size_t)row * NPROJ + PC_GA + col), gb = *(const GAS v2u*)(projb + (size_t)row * NPROJ + PC_GB + col);
        const f32x4 fa = {bflo(ga.x), bfhi(ga.x), bflo(ga.y), bfhi(ga.y)}, fb = {bflo(gb.x), bfhi(gb.x), bflo(gb.y), bfhi(gb.y)};
        const f32x4 v = sig4(fa) * (a0 + a1) + sig4(fb) * (b0 + b1);
        v2u w; w.x = pg8::cvt_pk_bf16(v[0], v[1]); w.y = pg8::cvt_pk_bf16(v[2], v[3]); *(GAS v2u*)(MR + (size_t)row * 1024 + col) = w; }
}
}
namespace mk {
constexpr int SD_LBR = 0, SD_LBI = 2048, SD_BBR = 4096, SD_BBI = 4096 + 32768, SD_PR = 4096 + 65536, SD_PI = 4096 + 65536 + 2048;
__device__ __forceinline__ float gelu_tanh_f(float x) { const float a = 0.7978845608028654f * (x + 0.044715f * x * x * x); return x * sigmf(2.f * a); }

__device__ __forceinline__ void ssm_stage_u(const bf16* projb, int row0, int ntok, int g, LAS float* U, int lane) {
    f32x4 v0 = {0.f, 0.f, 0.f, 0.f}, v1 = v0, v2 = v0, v3 = v0;
    if (lane < ntok) { const GAS v4u* p = (const GAS v4u*)(projb + (size_t)(row0 + lane) * NPROJ + g * 16); const v4u a = p[0], b = p[1]; unpack8(a, v0, v1); unpack8(b, v2, v3); }
    LAS f32x4* o = (LAS f32x4*)(U + lane * 16); o[0] = v0; o[1] = v1; o[2] = v2; o[3] = v3;
}
struct SsmCoef { float lr, li; float br[16], bi[16]; };
__device__ __forceinline__ void ssm_load_coef(const float* sd, int g, int lane, SsmCoef& c) {
    const int idx = g * 64 + lane; c.lr = sd[SD_LBR + idx]; c.li = sd[SD_LBI + idx];
#pragma unroll
    for (int q = 0; q < 4; ++q) { const f32x4 a = *(const GAS f32x4*)(sd + SD_BBR + idx * 16 + 4 * q), b = *(const GAS f32x4*)(sd + SD_BBI + idx * 16 + 4 * q);
#pragma unroll
        for (int e = 0; e < 4; ++e) { c.br[4 * q + e] = a[e]; c.bi[4 * q + e] = b[e]; } }
}
__device__ __forceinline__ void ssm_step(const SsmCoef& c, const LAS float* Ut, float& hr, float& hi) {
    const LAS f32x4* up = (const LAS f32x4*)Ut; float br4[4], bi4[4];
#pragma unroll
    for (int q = 0; q < 4; ++q) { const f32x4 u = up[q];
        br4[q] = fmaf(u[3], c.br[4 * q + 3], fmaf(u[2], c.br[4 * q + 2], fmaf(u[1], c.br[4 * q + 1], u[0] * c.br[4 * q])));
        bi4[q] = fmaf(u[3], c.bi[4 * q + 3], fmaf(u[2], c.bi[4 * q + 2], fmaf(u[1], c.bi[4 * q + 1], u[0] * c.bi[4 * q]))); }
    const float bur = (br4[0] + br4[1]) + (br4[2] + br4[3]), bui = (bi4[0] + bi4[1]) + (bi4[2] + bi4[3]);
    const float nr = fmaf(c.lr, hr, fmaf(-c.li, hi, bur)), ni = fmaf(c.lr, hi, fmaf(c.li, hr, bui)); hr = nr; hi = ni;
}
__device__ __forceinline__ void ssm_pass1(const Args& a, LAS unsigned char* lds, int gw, int NGW, int wave, int lane) {
    unsigned char* ws = a.ws; const bf16* projb = (const bf16*)(ws + WS_PROJ); const float* sd = (const float*)(ws + WS_SSMD); float* SST = (float*)(ws + WS_SST);
    LAS float* U = (LAS float*)(lds + wave * 8192);
    for (int gi = gw; gi < 4 * 32 * 16; gi += NGW) { const int cq = gi & 15, bg = gi >> 4, g = bg & 31, b = bg >> 5;
        SsmCoef c; ssm_load_coef(sd, g, lane, c);
#pragma unroll 1
        for (int k = 0; k < 4; ++k) { const int chunk = 4 * cq + k;
            ssm_stage_u(projb, b * SEQ + chunk * 64, 64, g, U, lane); LDS_WAIT();
            float hr = 0.f, hi = 0.f;
#pragma unroll 4
            for (int t = 0; t < 64; ++t) ssm_step(c, U + t * 16, hr, hi);
            SST[(size_t)(bg * 64 + chunk) * 128 + lane] = hr; SST[(size_t)(bg * 64 + chunk) * 128 + 64 + lane] = hi;
            LDS_WAIT(); asm volatile("" ::: "memory"); }
    }
}
__device__ __forceinline__ void ssm_pass3(const Args& a, LAS unsigned char* lds, int gw, int NGW, int wave, int lane) {
    unsigned char* ws = a.ws; const bf16* projb = (const bf16*)(ws + WS_PROJ); const float* sd = (const float*)(ws + WS_SSMD); const float* SST = (const float*)(ws + WS_SST);
    bf16* zb = (bf16*)(ws + WS_ZB);
    LAS float* U = (LAS float*)(lds + wave * 8192); LAS unsigned* H = (LAS unsigned*)(lds + wave * 8192 + 4096);
    const int ch = lane & 15, kq = lane >> 4;
    for (int it = gw; it < 2048 + 4096; it += NGW) {
        int g, row0, ntok, nchunk, chunk0 = 0, bg; float hr = 0.f, hi = 0.f;
        if (it < 2048) { const int cq = it & 15; bg = it >> 4; g = bg & 31; chunk0 = 4 * cq; row0 = (bg >> 5) * SEQ + chunk0 * 64; ntok = 64; nchunk = 4;
            const float pr = sd[SD_PR + g * 64 + lane], pi = sd[SD_PI + g * 64 + lane]; const float* sp = SST + (size_t)(bg * 64) * 128 + lane;
            for (int j0 = 0; j0 < chunk0; j0 += 4) { float sr[4], si[4];
#pragma unroll
                for (int j = 0; j < 4; ++j) { sr[j] = sp[(j0 + j) * 128]; si[j] = sp[(j0 + j) * 128 + 64]; }
#pragma unroll
                for (int j = 0; j < 4; ++j) { const float nr = fmaf(pr, hr, fmaf(-pi, hi, sr[j])), ni = fmaf(pr, hi, fmaf(pi, hr, si[j])); hr = nr; hi = ni; } } }
        else { bg = it - 2048; g = bg & 31; row0 = MP + (bg >> 5) * DSEQ; ntok = 8; nchunk = 1; hr = a.in[6][(size_t)bg * 64 + lane]; hi = a.in[7][(size_t)bg * 64 + lane]; }
        SsmCoef c; ssm_load_coef(sd, g, lane, c);
        bf16x8 cm[4];
#pragma unroll
        for (int s = 0; s < 4; ++s) { const int n0 = 16 * s + 4 * kq; const f32x4 cr = *(const GAS f32x4*)(a.in[25] + (size_t)(g * 16 + ch) * 64 + n0), ci = *(const GAS f32x4*)(a.in[26] + (size_t)(g * 16 + ch) * 64 + n0);
            v4u w; w.x = pk2(cr[0], -ci[0]); w.y = pk2(cr[1], -ci[1]); w.z = pk2(cr[2], -ci[2]); w.w = pk2(cr[3], -ci[3]); cm[s] = __builtin_bit_cast(bf16x8, w); }
        const float dch = a.in[27][g * 16 + ch];
        const int nblk = ntok == 64 ? 4 : 1, ntt = ntok == 64 ? 16 : 8;
#pragma unroll 1
        for (int kc = 0; kc < nchunk; ++kc) { const int rowc = row0 + kc * 64;
            ssm_stage_u(projb, rowc, ntok, g, U, lane); LDS_WAIT();
            for (int tb = 0; tb < nblk; ++tb) {
#pragma unroll 4
                for (int tt = 0; tt < ntt; ++tt) { ssm_step(c, U + (tb * 16 + tt) * 16, hr, hi); H[tt * 64 + lane] = pk2(hr, hi); }
                LDS_WAIT();
                f32x4 acc = {0.f, 0.f, 0.f, 0.f};
#pragma unroll
                for (int s = 0; s < 4; ++s) { const bf16x8 af = *(const LAS bf16x8*)(H + ch * 64 + 16 * s + 4 * kq); acc = __builtin_amdgcn_mfma_f32_16x16x32_bf16(af, cm[s], acc, 0, 0, 0); }
#pragma unroll
                for (int i = 0; i < 4; ++i) { const int tok = tb * 16 + 4 * kq + i;
                    if (tok < ntok) { const float y = acc[i] + dch * U[tok * 16 + ch]; zb[(size_t)(rowc + tok) * 512 + g * 16 + ch] = (bf16)f2bf(gelu_tanh_f(y)); } }
                LDS_WAIT(); asm volatile("" ::: "memory");
            } }
        if (it >= 2048) { a.out[O_HRE_S + (size_t)bg * 64 + lane] = hr; a.out[O_HIM_S + (size_t)bg * 64 + lane] = hi; }
        else if (chunk0 == 60) { a.out[O_HRE_P + (size_t)bg * 64 + lane] = hr; a.out[O_HIM_P + (size_t)bg * 64 + lane] = hi; }
    }
}
}
namespace mk {
struct Cx { float r, i; };
__device__ __forceinline__ Cx cmul(Cx a, Cx b) { return {a.r * b.r - a.i * b.i, a.r * b.i + a.i * b.r}; }
__device__ __forceinline__ Cx cfma(Cx a, Cx b, Cx c) { return {fmaf(a.r, b.r, fmaf(-a.i, b.i, c.r)), fmaf(a.r, b.i, fmaf(a.i, b.r, c.i))}; }
struct SsmBlk { bf16x8 bre, bim; Cx p1, p2, p3, p4; };
__device__ __forceinline__ void ssm2_load_blk(const float* sd, int g, int nb, int r32, int hi, SsmBlk& k) {
    const int idx = g * 64 + 32 * nb + r32;
    const float* br = sd + SD_BBR + idx * 16 + 8 * hi; const float* bi = sd + SD_BBI + idx * 16 + 8 * hi;
    const f32x4 a0 = *(const GAS f32x4*)br, a1 = *(const GAS f32x4*)(br + 4), b0 = *(const GAS f32x4*)bi, b1 = *(const GAS f32x4*)(bi + 4);
    k.bre = __builtin_bit_cast(bf16x8, pack8(a0, a1)); k.bim = __builtin_bit_cast(bf16x8, pack8(b0, b1));
    k.p1 = {sd[SD_LBR + idx], sd[SD_LBI + idx]}; k.p2 = cmul(k.p1, k.p1); k.p3 = cmul(k.p2, k.p1); k.p4 = cmul(k.p2, k.p2);
}
template <bool CORRECT>
__device__ __forceinline__ void ssm2_scan(f32x16& X, f32x16& Y, const SsmBlk& k, Cx& c, int hi) {
#pragma unroll
    for (int q = 0; q < 4; ++q)
#pragma unroll
        for (int j = 1; j < 4; ++j) { const Cx h = cfma(k.p1, {X[4 * q + j - 1], Y[4 * q + j - 1]}, {X[4 * q + j], Y[4 * q + j]}); X[4 * q + j] = h.r; Y[4 * q + j] = h.i; }
    Cx cin[4];
#pragma unroll
    for (int q = 0; q < 4; ++q) {
        Cx le0, le1;
        xhalf_both(X[4 * q + 3], le0.r, le1.r); xhalf_both(Y[4 * q + 3], le0.i, le1.i);
        const Cx ca = c, cb = cfma(k.p4, ca, le0);
        c = cfma(k.p4, cb, le1);
        cin[q] = hi ? cb : ca; }
    if (CORRECT) {
#pragma unroll
        for (int q = 0; q < 4; ++q) { const Cx t0 = cmul(k.p1, cin[q]), t1 = cmul(k.p2, cin[q]), t2 = cmul(k.p3, cin[q]), t3 = cmul(k.p4, cin[q]);
            X[4 * q] += t0.r; Y[4 * q] += t0.i; X[4 * q + 1] += t1.r; Y[4 * q + 1] += t1.i; X[4 * q + 2] += t2.r; Y[4 * q + 2] += t2.i; X[4 * q + 3] += t3.r; Y[4 * q + 3] += t3.i; } }
}
__device__ __forceinline__ bf16x8 ssm2_ufrag(const bf16* projb, int row0, int ntok, int g, int r32, int hi) {
    v4u w = {0u, 0u, 0u, 0u};
    if (r32 < ntok) w = *(const GAS v4u*)(projb + (size_t)(row0 + r32) * NPROJ + g * 16 + 8 * hi);
    return __builtin_bit_cast(bf16x8, w);
}
#define SSM_MFMA32(a, b, c) __builtin_amdgcn_mfma_f32_32x32x16_bf16(a, b, c, 0, 0, 0)
__device__ __forceinline__ void ssm2_pass1(const Args& a, int gw, int NGW, int lane) {
    unsigned char* ws = a.ws; const bf16* projb = (const bf16*)(ws + WS_PROJ); const float* sd = (const float*)(ws + WS_SSMD); float* SST = (float*)(ws + WS_SST);
    const int r32 = lane & 31, hi = lane >> 5;
    for (int gi = gw; gi < 4 * 32 * 16; gi += NGW) { const int cq = gi & 15, bg = gi >> 4, g = bg & 31, b = bg >> 5;
        SsmBlk k0, k1; ssm2_load_blk(sd, g, 0, r32, hi, k0); ssm2_load_blk(sd, g, 1, r32, hi, k1);
#pragma unroll 1
        for (int kc = 0; kc < 4; ++kc) { const int chunk = 4 * cq + kc; Cx c0 = {0.f, 0.f}, c1 = {0.f, 0.f};
#pragma unroll
            for (int blk = 0; blk < 2; ++blk) { const bf16x8 uf = ssm2_ufrag(projb, b * SEQ + chunk * 64 + 32 * blk, 32, g, r32, hi);
                { f32x16 X = SSM_MFMA32(uf, k0.bre, f32x16{}), Y = SSM_MFMA32(uf, k0.bim, f32x16{}); ssm2_scan<false>(X, Y, k0, c0, hi); }
                { f32x16 X = SSM_MFMA32(uf, k1.bre, f32x16{}), Y = SSM_MFMA32(uf, k1.bim, f32x16{}); ssm2_scan<false>(X, Y, k1, c1, hi); } }
            float* sp = SST + (size_t)(bg * 64 + chunk) * 128;
            if (hi == 0) { sp[r32] = c0.r; sp[64 + r32] = c0.i; } else { sp[32 + r32] = c1.r; sp[96 + r32] = c1.i; } }
    }
}
__device__ __forceinline__ void ssm2_pass3(const Args& a, LAS unsigned char* lds, int gw, int NGW, int wave, int lane) {
    unsigned char* ws = a.ws; const bf16* projb = (const bf16*)(ws + WS_PROJ); const float* sd = (const float*)(ws + WS_SSMD); const float* SST = (const float*)(ws + WS_SST);
    bf16* zb = (bf16*)(ws + WS_ZB);
    LAS unsigned* H = (LAS unsigned*)(lds + wave * 16384);
    LAS bf16* U16 = (LAS bf16*)(lds + wave * 16384 + 8192);
    const int r32 = lane & 31, hi = lane >> 5, ch = lane & 15, kq = lane >> 4;
    for (int it = gw; it < 2048 + 4096; it += NGW) {
        int g, row0, ntok, nblk, chunk0 = 0, bg; Cx c0 = {0.f, 0.f}, c1 = {0.f, 0.f};
        SsmBlk k0, k1;
        if (it < 2048) { const int cq = it & 15; bg = it >> 4; g = bg & 31; chunk0 = 4 * cq; row0 = (bg >> 5) * SEQ + chunk0 * 64; ntok = 32; nblk = 8;
            ssm2_load_blk(sd, g, 0, r32, hi, k0); ssm2_load_blk(sd, g, 1, r32, hi, k1);
            const Cx p0 = {sd[SD_PR + g * 64 + r32], sd[SD_PI + g * 64 + r32]}, p1 = {sd[SD_PR + g * 64 + 32 + r32], sd[SD_PI + g * 64 + 32 + r32]};
            const float* sp = SST + (size_t)(bg * 64) * 128 + r32;
            for (int j0 = 0; j0 < chunk0; j0 += 4) { Cx s0[4], s1[4];
#pragma unroll
                for (int j = 0; j < 4; ++j) { s0[j] = {sp[(j0 + j) * 128], sp[(j0 + j) * 128 + 64]}; s1[j] = {sp[(j0 + j) * 128 + 32], sp[(j0 + j) * 128 + 96]}; }
#pragma unroll
                for (int j = 0; j < 4; ++j) { c0 = cfma(p0, c0, s0[j]); c1 = cfma(p1, c1, s1[j]); } } }
        else { bg = it - 2048; g = bg & 31; row0 = MP + (bg >> 5) * DSEQ; ntok = 8; nblk = 1;
            ssm2_load_blk(sd, g, 0, r32, hi, k0); ssm2_load_blk(sd, g, 1, r32, hi, k1);
            c0 = {a.in[6][(size_t)bg * 64 + r32], a.in[7][(size_t)bg * 64 + r32]}; c1 = {a.in[6][(size_t)bg * 64 + 32 + r32], a.in[7][(size_t)bg * 64 + 32 + r32]}; }
        bf16x8 cm[4];
#pragma unroll
        for (int s = 0; s < 4; ++s) { const int n0 = 16 * s + 4 * kq; const f32x4 cr = *(const GAS f32x4*)(a.in[25] + (size_t)(g * 16 + ch) * 64 + n0), ci = *(const GAS f32x4*)(a.in[26] + (size_t)(g * 16 + ch) * 64 + n0);
            v4u w; w.x = pk2(cr[0], -ci[0]); w.y = pk2(cr[1], -ci[1]); w.z = pk2(cr[2], -ci[2]); w.w = pk2(cr[3], -ci[3]); cm[s] = __builtin_bit_cast(bf16x8, w); }
        const float dch = a.in[27][g * 16 + ch];
        Cx e0 = c0, e1 = c1;
#pragma unroll 1
        for (int blk = 0; blk < nblk; ++blk) { const int rowb = row0 + 32 * blk;
            const bf16x8 uf = ssm2_ufrag(projb, rowb, ntok, g, r32, hi);
            *(LAS bf16x8*)(U16 + r32 * 16 + 8 * hi) = uf;
            { f32x16 X = SSM_MFMA32(uf, k0.bre, f32x16{}), Y = SSM_MFMA32(uf, k0.bim, f32x16{}); ssm2_scan<true>(X, Y, k0, c0, hi);
              if (hi == 1) e0 = {X[3], Y[3]};
#pragma unroll
              for (int r = 0; r < 16; ++r) H[((r & 3) + 8 * (r >> 2) + 4 * hi) * 64 + r32] = pg8::cvt_pk_bf16(X[r], Y[r]); }
            { f32x16 X = SSM_MFMA32(uf, k1.bre, f32x16{}), Y = SSM_MFMA32(uf, k1.bim, f32x16{}); ssm2_scan<true>(X, Y, k1, c1, hi);
              if (hi == 1) e1 = {X[3], Y[3]};
#pragma unroll
              for (int r = 0; r < 16; ++r) H[((r & 3) + 8 * (r >> 2) + 4 * hi) * 64 + 32 + r32] = pg8::cvt_pk_bf16(X[r], Y[r]); }
            LDS_WAIT();
#pragma unroll
            for (int tb = 0; tb < 2; ++tb) { f32x4 acc = {0.f, 0.f, 0.f, 0.f};
#pragma unroll
                for (int s = 0; s < 4; ++s) { const bf16x8 af = *(const LAS bf16x8*)(H + (16 * tb + ch) * 64 + 16 * s + 4 * kq); acc = __builtin_amdgcn_mfma_f32_16x16x32_bf16(af, cm[s], acc, 0, 0, 0); }
#pragma unroll
                for (int i = 0; i < 4; ++i) { const int tok = 16 * tb + 4 * kq + i;
                    if (tok < ntok) { const float y = acc[i] + dch * bf1(U16[tok * 16 + ch]); zb[(size_t)(rowb + tok) * 512 + g * 16 + ch] = (bf16)f2bf(gelu_tanh_f(y)); } } }
            LDS_WAIT(); asm volatile("" ::: "memory");
        }
        if (it >= 2048) { if (hi == 1) { a.out[O_HRE_S + (size_t)bg * 64 + r32] = e0.r; a.out[O_HIM_S + (size_t)bg * 64 + r32] = e0.i; a.out[O_HRE_S + (size_t)bg * 64 + 32 + r32] = e1.r; a.out[O_HIM_S + (size_t)bg * 64 + 32 + r32] = e1.i; } }
        else if (chunk0 == 60 && hi == 0) { a.out[O_HRE_P + (size_t)bg * 64 + r32] = c0.r; a.out[O_HIM_P + (size_t)bg * 64 + r32] = c0.i; a.out[O_HRE_P + (size_t)bg * 64 + 32 + r32] = c1.r; a.out[O_HIM_P + (size_t)bg * 64 + 32 + r32] = c1.i; }
    }
}
}
namespace attn {
constexpr int KSLOT = 12288, VSLOT = 8192, L_K = 0, L_V = 3 * KSLOT, L_WS = L_V + 3 * VSLOT, L_OST = L_WS + 8 * 256, L_END = L_OST + 8 * 4096;
static_assert(L_END <= mk::RING_BYTES, "attention LDS map");
constexpr int SEQ = 4096, DMK = 768, DMV = 512, DMO = 512;
constexpr float C2 = 0.10206207261596577f * 1.4426950408889634f;
#define A_MFMA(a, b, c) __builtin_amdgcn_mfma_f32_32x32x16_bf16(a, b, c, 0, 0, 0)
#define A_WAIT_BAR(N) asm volatile("s_waitcnt vmcnt(" #N ") lgkmcnt(0)\n\ts_barrier" ::: "memory")
__device__ __forceinline__ int crow(int r, int hi) { return (r & 3) + 8 * (r >> 2) + 4 * hi; }
__device__ __forceinline__ unsigned cvtpk(float lo, float hi) { unsigned r; asm("v_cvt_pk_bf16_f32 %0, %1, %2" : "=v"(r) : "v"(lo), "v"(hi)); return r; }
__device__ __forceinline__ void glds16(const void* g, unsigned lds_base) {
    unsigned sv; asm volatile("s_mov_b32 %0, m0\n\ts_mov_b32 m0, %2\n\ts_nop 0\n\tglobal_load_lds_dwordx4 %1, off\n\ts_mov_b32 m0, %0" : "=&s"(sv) : "v"(g), "s"(lds_base) : "memory"); }
typedef __attribute__((address_space(3))) const char* lds_cptr;
typedef short v4i16_t __attribute__((ext_vector_type(4)));
__device__ __forceinline__ s16x4 vtr(lds_cptr p) { return __builtin_bit_cast(s16x4, __builtin_amdgcn_ds_read_tr16_b64_v4i16((__attribute__((address_space(3))) v4i16_t*)p)); }

__device__ __forceinline__ void prompt_unit(int b, int h, int qb, const bf16* Q, const bf16* __restrict__ K, const bf16* __restrict__ V, bf16* O, const float* cs, float negB, char* lds) {
    const int tid = threadIdx.x, lane = tid & 63, r32 = lane & 31, hi = lane >> 5; const int wid = __builtin_amdgcn_readfirstlane(tid >> 6);
    const long rowbase = (long)b * SEQ; const int q0 = qb * 256, NT = (q0 + 256) / 64;
    const unsigned lds0 = (unsigned)(uintptr_t)lds; float* wsf = (float*)(lds + L_WS) + wid * 64;
    const bf16* ksrcA = K + rowbase * DMK + h * 96 + (long)lane * DMK + wid * 8;
    const bf16* ksrcB = K + rowbase * DMK + h * 96 + (long)lane * DMK + (8 + (wid & 3)) * 8;
    const bf16* vsrc = V + rowbase * DMV + h * 64 + (long)(16 * (wid & 3) + (lane >> 2)) * DMV + (wid >> 2) * 32 + (lane & 3) * 8;
    const unsigned kdstA = lds0 + L_K + wid * 1024, kdstB = lds0 + L_K + (8 + (wid & 3)) * 1024, vdst = lds0 + L_V + wid * 1024;
#define A_DMA(t, s) do { glds16(ksrcA + (long)(t) * 64 * DMK, (unsigned)__builtin_amdgcn_readfirstlane(kdstA + (s) * KSLOT)); glds16(ksrcB + (long)(t) * 64 * DMK, (unsigned)__builtin_amdgcn_readfirstlane(kdstB + (s) * KSLOT)); \
                         glds16(vsrc + (long)(t) * 64 * DMV, (unsigned)__builtin_amdgcn_readfirstlane(vdst + (s) * VSLOT)); } while (0)
    const lds_cptr vp0 = (lds_cptr)lds + L_V + ((lane >> 4) & 1) * 32 + (lane & 3) * 8 + (4 * hi + ((lane & 15) >> 2)) * 64;
    const lds_cptr kp0 = (lds_cptr)lds + L_K + hi * 1024 + r32 * 16;
    A_DMA(0, 0); A_DMA(1, 1);
    bf16x8 qr[6];
    { const long row = rowbase + q0 + wid * 32 + r32; const bf16* qp = Q + row * 768 + h * 96 + 8 * hi;
      v4u w[6];
#pragma unroll
      for (int s = 0; s < 6; ++s) w[s] = *(const GAS v4u*)(qp + 16 * s);
      float ss = 0.f;
#pragma unroll
      for (int s = 0; s < 6; ++s) ss += mk::sq8(w[s]);
      ss += __shfl_xor(ss, 32);
      const float rn = rsq(ss * (1.f / 96.f) + mk::EPS) * C2;
#pragma unroll
      for (int s = 0; s < 4; ++s) { f32x4 a, c; mk::unpack8(w[s], a, c); qr[s] = __builtin_bit_cast(bf16x8, mk::pack8(a * rn, c * rn)); }
      const float* csr = cs + (size_t)(q0 + wid * 32 + r32) * 32 + 8 * hi;
      f32x4 x1a, x1b, x2a, x2b; mk::unpack8(w[4], x1a, x1b); mk::unpack8(w[5], x2a, x2b);
      const f32x4 ca = *(const GAS f32x4*)csr, cb = *(const GAS f32x4*)(csr + 4), sa = *(const GAS f32x4*)(csr + 16), sb = *(const GAS f32x4*)(csr + 20);
      qr[4] = __builtin_bit_cast(bf16x8, mk::pack8((x1a * ca - x2a * sa) * rn, (x1b * cb - x2b * sb) * rn));
      qr[5] = __builtin_bit_cast(bf16x8, mk::pack8((x2a * ca + x1a * sa) * rn, (x2b * cb + x1b * sb) * rn)); }
    f32x16 o0 = f32x16{}, o1 = f32x16{}; float l_reg = 0.f;
    f32x16 nb16;
#pragma unroll
    for (int r = 0; r < 16; ++r) nb16[r] = negB;
    const int qrel = wid * 32 + r32;
    int slot = 0;
    for (int t = 0; t < NT; ++t) {
        if (t + 1 < NT) { A_WAIT_BAR(3); } else { A_WAIT_BAR(0); }
        if (t + 2 < NT) { const int s2 = slot >= 1 ? slot - 1 : 2; A_DMA(t + 2, s2); }
        const lds_cptr kp = kp0 + slot * KSLOT; const lds_cptr vp_ = vp0 + slot * VSLOT;
        f32x16 p0 = nb16, p1 = nb16;
#pragma unroll
        for (int s = 0; s < 6; ++s) { const bf16x8 ka = *(const __attribute__((address_space(3))) bf16x8*)(kp + s * 2048), kb = *(const __attribute__((address_space(3))) bf16x8*)(kp + s * 2048 + 512);
            p0 = A_MFMA(ka, qr[s], p0); p1 = A_MFMA(kb, qr[s], p1); }
        if (t >= NT - 4) { const int kb0 = 64 * (t - (NT - 4)) + 4 * hi;
#pragma unroll
            for (int r = 0; r < 16; ++r) { const int kv = kb0 + (r & 3) + 8 * (r >> 2); if (kv > qrel) p0[r] = -INFINITY; if (kv + 32 > qrel) p1[r] = -INFINITY; } }
        float sacc = 0.f;
#pragma unroll
        for (int r = 0; r < 16; ++r) { p0[r] = __builtin_amdgcn_exp2f(p0[r]); p1[r] = __builtin_amdgcn_exp2f(p1[r]); sacc += p0[r] + p1[r]; }
        l_reg += sacc;
        v4u pw[4];
        pw[0] = (v4u){cvtpk(p0[0], p0[1]), cvtpk(p0[2], p0[3]), cvtpk(p0[4], p0[5]), cvtpk(p0[6], p0[7])};
        pw[1] = (v4u){cvtpk(p0[8], p0[9]), cvtpk(p0[10], p0[11]), cvtpk(p0[12], p0[13]), cvtpk(p0[14], p0[15])};
        pw[2] = (v4u){cvtpk(p1[0], p1[1]), cvtpk(p1[2], p1[3]), cvtpk(p1[4], p1[5]), cvtpk(p1[6], p1[7])};
        pw[3] = (v4u){cvtpk(p1[8], p1[9]), cvtpk(p1[10], p1[11]), cvtpk(p1[12], p1[13]), cvtpk(p1[14], p1[15])};
#pragma unroll
        for (int i = 0; i < 8; ++i) { const s16x4 vlo = vtr(vp_ + ((i >> 2) * 4096 + (i & 3) * 1024)), vhi = vtr(vp_ + ((i >> 2) * 4096 + (i & 3) * 1024 + 512));
            const bf16x8 vf = (bf16x8){vlo[0], vlo[1], vlo[2], vlo[3], vhi[0], vhi[1], vhi[2], vhi[3]};
            if (i < 4) o0 = A_MFMA(__builtin_bit_cast(bf16x8, pw[i & 3]), vf, o0); else o1 = A_MFMA(__builtin_bit_cast(bf16x8, pw[i & 3]), vf, o1); }
        slot = slot == 2 ? 0 : slot + 1;
    }
    l_reg += __shfl_xor(l_reg, 32);
    if (hi == 0) wsf[r32] = l_reg;
    asm volatile("s_waitcnt lgkmcnt(0)" ::: "memory");
    bf16* Ow = O + (rowbase + q0 + wid * 32) * DMO + h * 64; bf16* stg = (bf16*)(lds + L_OST) + wid * 2048;
#pragma unroll
    for (int r = 0; r < 16; ++r) { const int orow = crow(r, hi); const float rl = __builtin_amdgcn_rcpf(wsf[orow]);
        stg[orow * 64 + r32] = (bf16)f2bf(o0[r] * rl); stg[orow * 64 + 32 + r32] = (bf16)f2bf(o1[r] * rl); }
    asm volatile("s_waitcnt lgkmcnt(0)" ::: "memory");
#pragma unroll
    for (int i = 0; i < 4; ++i) { const int row = i * 8 + (lane >> 3), chn = lane & 7; *(v4u*)(Ow + (long)row * DMO + chn * 8) = *(const v4u*)(stg + row * 64 + chn * 8); }
    asm volatile("s_waitcnt vmcnt(0) lgkmcnt(0)\n\ts_barrier" ::: "memory");
#undef A_DMA
}
}
namespace sattn {
using attn::crow; using attn::cvtpk; using attn::vtr; using attn::lds_cptr;
constexpr int CS = 1040;
constexpr int IMG_SLOT = 36 * CS, KPE_OFF = 32 * CS;
constexpr int S_IMG = 0, S_QA = 3 * IMG_SLOT, S_PX = S_QA + 16384, S_RKP = S_PX + 8192, S_KSS = S_RKP + 2048, S_QR = S_KSS + 3 * 256, S_END = S_QR + 2048;
constexpr int S_QT = IMG_SLOT;
static_assert(S_END <= mk::LDSCTL_OFF, "sample attention LDS map");
#define S_MFMA(a, b, c) __builtin_amdgcn_mfma_f32_32x32x16_bf16(a, b, c, 0, 0, 0)
typedef __attribute__((address_space(3))) bf16x8 lbf16x8;
typedef __attribute__((address_space(3))) f32x4 lf32x4;
typedef __attribute__((address_space(3))) v4u lv4u;
typedef __attribute__((address_space(3))) v2u lv2u;
typedef __attribute__((address_space(3))) float lfloat;
#define S_BAR() asm volatile("s_waitcnt lgkmcnt(0)\n\ts_barrier" ::: "memory")
#define S_BARV() asm volatile("s_waitcnt vmcnt(0) lgkmcnt(0)\n\ts_barrier" ::: "memory")

__device__ __forceinline__ void sample_unit(const mk::Args& a, int seq, int hh, float negB, char* lds) {
    using namespace mk;
    const int tid = threadIdx.x, lane = tid & 63, r32 = lane & 31, hi = lane >> 5; const int wid = __builtin_amdgcn_readfirstlane(tid >> 6);
    unsigned char* ws = a.ws;
    const int* pt = (const int*)a.in[8] + seq * 64;
    const float* cache_ckv = a.in[4]; const float* cache_kpe = a.in[5];
    constexpr int NTC = 128, NT = NTC + 1;
    f32x4 pfa[8]; f32x4 pfka;
    const int ptv = pt[lane];
#define S_LOAD(t, pf, pfk) do { const int key0_ = (t) * 64; const int page_ = __builtin_amdgcn_readlane(ptv, key0_ >> 7); const size_t prow_ = (size_t)page_ * 128 + (key0_ & 127) + 8 * wid; \
        const float* cs_ = cache_ckv + prow_ * 256 + lane * 4;                  \
        _Pragma("unroll") for (int i_ = 0; i_ < 8; ++i_) pf[i_] = *(const GAS f32x4*)(cs_ + i_ * 256); \
        pfk = *(const GAS f32x4*)(cache_kpe + (prow_ + (lane >> 3)) * 32 + (lane & 7) * 4); } while (0)
#define S_CONVERT(slot, pf, pfk) do { char* ib_ = lds + S_IMG + (slot) * IMG_SLOT; const int chn_ = lane >> 1; \
        _Pragma("unroll") for (int i_ = 0; i_ < 8; ++i_) { const int key_ = 8 * wid + i_; v2u w2_; w2_.x = pg8::cvt_pk_bf16(pf[i_][0], pf[i_][1]); w2_.y = pg8::cvt_pk_bf16(pf[i_][2], pf[i_][3]); \
            *(lv2u*)(ib_ + chn_ * CS + key_ * 16 + (lane & 1) * 8) = w2_; } \
        { const int key_ = 8 * wid + (lane >> 3), seg_ = lane & 7; float s_ = (pfk[0] * pfk[0] + pfk[1] * pfk[1]) + (pfk[2] * pfk[2] + pfk[3] * pfk[3]); \
          s_ = sum8_dpp(s_); \
          v2u w_; w_.x = pk2(pfk[0], pfk[1]); w_.y = pk2(pfk[2], pfk[3]); *(lv2u*)(ib_ + KPE_OFF + (seg_ >> 1) * CS + key_ * 16 + (seg_ & 1) * 8) = w_; \
          if (seg_ == 0) *(lfloat*)(lds + S_KSS + (slot) * 256 + key_ * 4) = s_; } } while (0)
    S_LOAD(0, pfa, pfka);
    for (int rep_su = 0; rep_su < REP_SETUP; ++rep_su) {
    LAS float* QT = (LAS float*)(lds + S_QT);
    {
      const int col = tid >> 4, sg = tid & 15, h = 4 * hh + (col >> 3), q = col & 7;
      const bf16* qp = (const bf16*)(ws + WS_QB) + (size_t)(MP + seq * 8 + q) * 768 + h * 96 + 6 * sg;
      const unsigned w0 = *(const GAS unsigned*)qp, w1 = *(const GAS unsigned*)(qp + 2), w2 = *(const GAS unsigned*)(qp + 4);
      const float v[6] = {bflo(w0), bfhi(w0), bflo(w1), bfhi(w1), bflo(w2), bfhi(w2)};
      float ss = (v[0] * v[0] + v[1] * v[1]) + (v[2] * v[2] + v[3] * v[3]) + (v[4] * v[4] + v[5] * v[5]);
      ss = sum8_dpp(ss); ss += __builtin_bit_cast(float, __builtin_amdgcn_update_dpp(0, __builtin_bit_cast(int, ss), 0x140, 0xF, 0xF, true));
      const float rn = rsq(ss * (1.f / 96.f) + EPS) * attn::C2;
#pragma unroll
      for (int e = 0; e < 6; ++e) QT[col * 96 + 6 * sg + e] = v[e] * rn; }
    __syncthreads();
    {
      const int col = tid >> 4, j = tid & 15, q = col & 7; const float* gt = (const float*)(ws + WS_GT); const float* csr = (const float*)(ws + WS_CS) + (size_t)(SEQ + q) * 32;
      LAS f32x4* np = (LAS f32x4*)(QT + col * 96 + 4 * j); const f32x4 g4 = *(const GAS f32x4*)(gt + 4 * j); *np = *np * g4;
      const float x1 = QT[col * 96 + 64 + j], x2 = QT[col * 96 + 80 + j], c = csr[j], sn = csr[16 + j], g = gt[64 + j];
      QT[col * 96 + 64 + j] = (x1 * c - x2 * sn) * g; QT[col * 96 + 80 + j] = (x2 * c + x1 * sn) * g; }
    __syncthreads();
    if (tid < 128) { const int col = tid & 31, chn = tid >> 5; const LAS float* s = QT + col * 96 + 64 + chn * 8;
        v4u w; w.x = pk2(s[0], s[1]); w.y = pk2(s[2], s[3]); w.z = pk2(s[4], s[5]); w.w = pk2(s[6], s[7]);
        *(lv4u*)(lds + S_QR + chn * 512 + col * 16) = w; }
    { const int col = tid & 31, cg = tid >> 5, h = 4 * hh + (col >> 3); const float* wuk = a.in[14];
      const LAS f32x4* qv = (const LAS f32x4*)(QT + col * 96);
#pragma unroll 1
      for (int cc = 0; cc < 2; ++cc) { unsigned wv[4];
#pragma unroll
          for (int e2 = 0; e2 < 4; ++e2) { const int c = cg * 16 + cc * 8 + 2 * e2; const GAS f32x4* wp0 = (const GAS f32x4*)(wuk + ((size_t)c * 8 + h) * 64); const GAS f32x4* wp1 = wp0 + 128; float s0 = 0.f, s1 = 0.f;
#pragma unroll 8
              for (int d4 = 0; d4 < 16; ++d4) { const f32x4 qq = qv[d4], w0 = wp0[d4], w1 = wp1[d4];
                  s0 += (w0[0] * qq[0] + w0[1] * qq[1]) + (w0[2] * qq[2] + w0[3] * qq[3]); s1 += (w1[0] * qq[0] + w1[1] * qq[1]) + (w1[2] * qq[2] + w1[3] * qq[3]); }
              wv[e2] = pk2(s0, s1); }
          *(lv4u*)(lds + S_QA + (cg * 2 + cc) * 512 + col * 16) = (v4u){wv[0], wv[1], wv[2], wv[3]}; } }
    S_BARV();
    }
    const int hl = wid & 3, rb = wid >> 2;
    bf16x8 wf[16];
    { const bf16* wt = (const bf16*)(ws + WS_WUKS) + (size_t)((4 * hh + hl) * 64 + 32 * rb + r32) * 256 + 8 * hi;
#pragma unroll
      for (int s = 0; s < 16; ++s) wf[s] = __builtin_bit_cast(bf16x8, *(const GAS v4u*)(wt + 16 * s)); }
    const int kb16 = wid >> 1, cb16 = wid & 1, l15 = lane & 15, g4 = lane >> 4;
    S_CONVERT(0, pfa, pfka);
    S_LOAD(1, pfa, pfka);
    S_BAR();
    const int fb0 = S_IMG + hi * CS + r32 * 16;
    const int sab = S_IMG + g4 * CS + (16 * kb16 + l15) * 16, skb = S_IMG + KPE_OFF + g4 * CS + (16 * kb16 + l15) * 16;
    const int sqb = S_QA + g4 * 512 + (16 * cb16 + l15) * 16, sqr = S_QR + g4 * 512 + (16 * cb16 + l15) * 16;
    const int chl = 2 * ((lane >> 4) & 1) + ((lane & 3) >> 1);
    const int vb = S_IMG + (4 * wid + chl) * CS + (lane & 1) * 8 + 16 * (4 * hi + ((lane & 15) >> 2));
    const int hcol = 2 * cb16 + (l15 >> 3), qcol = l15 & 7;
    f32x16 o0 = f32x16{}; float l_reg = 0.f; f32x4 sraw = {0.f, 0.f, 0.f, 0.f};
    int sl_n = 0, sl_p = 2;
#define SB0() __builtin_amdgcn_sched_barrier(0)
#define S_BLK_NORMS(t) do { if (t + 1 < NT) { const lds_cptr ib = (lds_cptr)lds + sl_n * IMG_SLOT; bf16x8 fa[4], fb[4]; \
        _Pragma("unroll") for (int j = 0; j < 4; ++j) fa[j] = *(const lbf16x8*)(ib + fb0 + 2 * CS * j); SB0(); \
        __builtin_amdgcn_s_setprio(1); \
        _Pragma("unroll") for (int kb = 0; kb < 2; ++kb) { f32x16 n0 = f32x16{}; \
          _Pragma("unroll") for (int gq = 0; gq < 4; ++gq) { \
            if (gq & 1) { if (gq < 3 || kb == 0) { _Pragma("unroll") for (int j = 0; j < 4; ++j) fa[j] = *(const lbf16x8*)(ib + fb0 + 2 * CS * ((4 * (gq + 1) + j) & 15) + 512 * (gq < 3 ? kb : 1)); } SB0(); \
                          _Pragma("unroll") for (int j = 0; j < 4; ++j) n0 = S_MFMA(wf[4 * gq + j], fb[j], n0); SB0(); } \
            else        { _Pragma("unroll") for (int j = 0; j < 4; ++j) fb[j] = *(const lbf16x8*)(ib + fb0 + 2 * CS * (4 * (gq + 1) + j) + 512 * kb); SB0(); \
                          _Pragma("unroll") for (int j = 0; j < 4; ++j) n0 = S_MFMA(wf[4 * gq + j], fa[j], n0); SB0(); } } \
          float s0 = 0.f; \
          _Pragma("unroll") for (int r = 0; r < 16; ++r) s0 += n0[r] * n0[r]; \
          s0 = xhalf_sum(s0); \
          if (hi == 0) *(lfloat*)(lds + S_RKP + ((rb * 4 + hl) * 64 + 32 * kb + r32) * 4) = s0; } \
        __builtin_amdgcn_s_setprio(0); } } while (0)
#define S_BLK_SCORES(t) do { if (t + 1 < NT) { const lds_cptr ib = (lds_cptr)lds + sl_n * IMG_SLOT; f32x4 sacc = {0.f, 0.f, 0.f, 0.f}; \
        _Pragma("unroll") \
        for (int s = 0; s < 8; ++s) { const bf16x8 fa_ = *(const lbf16x8*)(ib + sab + 4 * CS * s), fq_ = *(const lbf16x8*)((lds_cptr)lds + sqb + 2048 * s); sacc = __builtin_amdgcn_mfma_f32_16x16x32_bf16(fa_, fq_, sacc, 0, 0, 0); } \
        { const bf16x8 fa_ = *(const lbf16x8*)(ib + skb), fq_ = *(const lbf16x8*)((lds_cptr)lds + sqr); sacc = __builtin_amdgcn_mfma_f32_16x16x32_bf16(fa_, fq_, sacc, 0, 0, 0); } \
        sraw = sacc; } } while (0)
#define S_BLK_PV(t) do { if (t >= 0) { const lds_cptr ib = (lds_cptr)lds + sl_p * IMG_SLOT; const lds_cptr px = (lds_cptr)lds + S_PX + (t & 1) * 4096 + lane * 16; \
        _Pragma("unroll") \
            for (int k = 0; k < 4; ++k) { const s16x4 vlo = vtr(ib + vb + 256 * k), vhi = vtr(ib + vb + 256 * k + 128); \
                const bf16x8 vf = (bf16x8){vlo[0], vlo[1], vlo[2], vlo[3], vhi[0], vhi[1], vhi[2], vhi[3]}; \
                o0 = S_MFMA(*(const lbf16x8*)(px + k * 1024), vf, o0); } } } while (0)
#define S_BLK_CONV(t, PF, PFK) do { \
          if (t + 2 < NTC) { S_CONVERT(sl_w, PF, PFK); } \
          else if (t + 2 == NTC) { int tq = threadIdx.x; asm volatile("" : "+v"(tq)); \
              char* ib_ = lds + S_IMG + sl_w * IMG_SLOT; \
              if (tq < 256) { const int key = tq >> 5, chn = tq & 31; *(lv4u*)(ib_ + chn * CS + key * 16) = *(const GAS v4u*)((const bf16*)(ws + WS_CKVS) + (size_t)(seq * 8 + key) * 256 + chn * 8); } \
              if (tq < 32) { const int key = tq >> 2, chn = tq & 3; *(lv4u*)(ib_ + KPE_OFF + chn * CS + key * 16) = *(const GAS v4u*)((const bf16*)(ws + WS_KPES) + (size_t)(seq * 8 + key) * 32 + chn * 8); } \
              if (tq < 8) { const bf16* kp = (const bf16*)(ws + WS_KPES) + (size_t)(seq * 8 + tq) * 32; float s = 0.f; for (int i = 0; i < 32; ++i) { const float v = bf1(kp[i]); s += v * v; } \
                  *(lfloat*)(lds + S_KSS + sl_w * 256 + tq * 4) = s; } } \
          if (t + 3 < NTC) S_LOAD(t + 3, PF, PFK); } while (0)
#define S_TILE(t, PF, PFK) do { \
        const int sl_w = 3 - sl_n - sl_p; \
          \
        S_ORDER_BODY(t, PF, PFK); \
        S_BAR(); \
        if (t + 1 < NT) { const int kof = (16 * kb16 + 4 * g4) * 4; \
            const f32x4 p0 = *(const lf32x4*)(lds + S_RKP + hcol * 256 + kof), p1 = *(const lf32x4*)(lds + S_RKP + 1024 + hcol * 256 + kof), ks = *(const lf32x4*)(lds + S_KSS + sl_n * 256 + kof); \
            float p[4]; \
        _Pragma("unroll") \
            for (int e = 0; e < 4; ++e) { const float rk = rsq((p0[e] + p1[e] + ks[e]) * (1.f / 96.f) + EPS); p[e] = __builtin_amdgcn_exp2f(fmaf(sraw[e], rk, negB)); \
                if (t + 1 == NTC) { const int key = 16 * kb16 + 4 * g4 + e; if (key > qcol) p[e] = 0.f; } } \
            l_reg += (p[0] + p[1]) + (p[2] + p[3]); \
              \
            *(lv2u*)(lds + S_PX + ((t + 1) & 1) * 4096 + kb16 * 1024 + (16 * cb16 + l15 + 32 * (g4 & 1)) * 16 + 8 * (g4 >> 1)) = (v2u){cvtpk(p[0], p[1]), cvtpk(p[2], p[3])}; } \
        sl_p = sl_n; sl_n = sl_w; \
        S_BAR(); \
    } while (0)
    for (int t = -1; t < NT; ++t) { S_TILE(t, pfa, pfka); }
#undef S_BLK_NORMS
#undef S_BLK_SCORES
#undef S_BLK_PV
#undef S_BLK_CONV
#undef SB0
#undef S_TILE
    LAS float* OL = (LAS float*)(lds + S_IMG); LAS float* LL = (LAS float*)(lds + S_IMG + 32768);
    LL[wid * 64 + lane] = l_reg;
#pragma unroll
    for (int r = 0; r < 16; ++r) OL[crow(r, hi) * 256 + 32 * wid + r32] = o0[r];
    S_BAR();
    for (int rep_ep = 0; rep_ep < REP_EPI; ++rep_ep) { const float* wuv = a.in[15]; bf16* bout = (bf16*)(ws + WS_BOUT); asm volatile("" ::: "memory");
#pragma unroll 1
      for (int ci = 0; ci < 4; ++ci) { const int col = 4 * wid + ci, h = 4 * hh + (col >> 3), q = col & 7; float lsum = 0.f;
#pragma unroll
          for (int w8 = (col >> 4); w8 < 8; w8 += 2) for (int gg = 0; gg < 4; ++gg) lsum += LL[w8 * 64 + gg * 16 + (col & 15)];
          const float inv = 1.f / lsum;
          const LAS f32x4* lat = (const LAS f32x4*)(OL + col * 256); float acc = 0.f;
#pragma unroll 16
          for (int c4 = 0; c4 < 64; ++c4) { const f32x4 lv = lat[c4]; const float* wp = wuv + ((size_t)(4 * c4) * 8 + h) * 64 + lane;
              acc = fmaf(lv[0], wp[0], acc); acc = fmaf(lv[1], wp[512], acc); acc = fmaf(lv[2], wp[1024], acc); acc = fmaf(lv[3], wp[1536], acc); }
          bout[(size_t)(MP + seq * 8 + q) * 512 + h * 64 + lane] = (bf16)f2bf(acc * inv); } }
    S_BARV();
#undef S_LOAD
#undef S_CONVERT
}
}
namespace mk {
__global__ void __launch_bounds__(NWAVES * 64, 2) mk_fwd(Args args) {
    extern __shared__ __attribute__((aligned(16))) unsigned char lds_raw[];
    LAS unsigned char* lds = (LAS unsigned char*)lds_raw;
    volatile LAS unsigned* MISC = (volatile LAS unsigned*)(lds + MISC_OFF);
    const int tid = threadIdx.x, lane = tid & 63, wave = __builtin_amdgcn_readfirstlane(tid >> 6);
    const int G = gridDim.x; const int bx = blockIdx.x; const int vcu = (G % 8 == 0) ? (bx % 8) * (G / 8) + bx / 8 : bx;
    unsigned char* ws = args.ws;
    gu32* ctl = (gu32*)(ws + WS_CTL);
    for (int u = tid; u < (LDS_BYTES - LDSCTL_OFF) / 4; u += NWAVES * 64) ((LAS unsigned*)(lds + LDSCTL_OFF))[u] = 0u;
    __syncthreads();
    XcdBarrier bar = xcd_barrier_post((unsigned*)(ctl + CW_BAR), MISC + 8);
    const int lo = args.ph_lo, hi = args.ph_hi;
#define IN(k) (lo <= (k) && (k) < hi)
#define BOTH(k) (IN(k) && IN((k) + 1))
#if PROF_K >= 100
    unsigned long long* ph_st = (unsigned long long*)(ws + WS_CTL + 786432); int ph_k = 0;
#define PH_STAMP() do { if (bx == 0 && tid == 0) ph_st[ph_k] = __builtin_amdgcn_s_memrealtime(); ++ph_k; } while (0)
#define GRID_BAR() do { xcd_barrier(bar); PH_STAMP(); } while (0)
    PH_STAMP();
#else
#define GRID_BAR() xcd_barrier(bar)
#endif
    float* ssq_q = (float*)(ws + CTL_SSQ_Q); float* ssq_kv = (float*)(ws + CTL_SSQ_KV); float* ssq_x1 = (float*)(ws + CTL_SSQ_X1); float* ssq_x2 = (float*)(ws + CTL_SSQ_X2);
    bf16* projb = (bf16*)(ws + WS_PROJ);

    if (IN(0)) { for (int rep = 0; rep < REP_P0; ++rep) { p0_prologue(args, lds, vcu, G, wave, lane); __syncthreads(); } if (BOTH(0)) GRID_BAR(); }

    if (IN(1)) {
        pg8::Gemm g{(const bf16*)(ws + WS_XB), (const bf16*)(ws + WS_WIN), M, NPROJ, 1024, 1024, 1024}; pg8::StaticOrder S; S.init(M, NPROJ, G, bx);
        EpiG1 E{projb, (const float*)(ws + WS_RX), ssq_q, ssq_kv};
        pg8::gemm_phase<EpiG1, pg8::StaticOrder, true, true>(lds, g, S, E);
#if REP_P1 > 1
        GRID_BAR(); for (int i = bx * 512 + tid; i < M; i += G * 512) { ssq_q[i] = 0.f; ssq_kv[i] = 0.f; } GRID_BAR();
        pg8::gemm_phase<EpiG1, pg8::StaticOrder, true, true>(lds, g, S, E);
#endif
        {
          const int r1 = (int)(((long)(M / 256) * (NPROJ / 256)) % G); const int c2 = r1 ? bx - r1 : bx, G2 = r1 ? G - r1 : G;
          if (c2 >= 0) { pg8::Gemm g2{(const bf16*)(ws + WS_PB), (const bf16*)(ws + WS_WPLE), M, 1024, 256, 256, 256}; pg8::StaticOrder S2; S2.init(M, 1024, G2, c2);
            EpiRowScale E2{(bf16*)(ws + WS_PW), 1024, nullptr, 0.f};
            pg8::gemm_phase<EpiRowScale, pg8::StaticOrder, true, true>(lds, g2, S2, E2); } }
        if (BOTH(1)) GRID_BAR();
    }
    if (IN(2)) for (int rep_ph = 0; rep_ph < REP_P2; ++rep_ph) { if (rep_ph) __syncthreads();
        { pg8::Gemm g{projb + PC_Q, (const bf16*)(ws + WS_WUQ), M, 768, 384, NPROJ, 384}; pg8::StaticOrder S; S.init(M, 768, G, bx);
          EpiRowScale E{(bf16*)(ws + WS_QB), 768, ssq_q, 1.f / 384.f};
          pg8::gemm_phase<EpiRowScale, pg8::StaticOrder, true, true>(lds, g, S, E); }
        { pg8::Gemm g{projb + PC_KV, (const bf16*)(ws + WS_WUKV), M, 1024, 256, NPROJ, 256}; pg8::PromptPlusTail S; S.S.init(MP, 1024, G, bx); S.w0 = 204; S.bx = bx; S.pm0 = MP / 256;
          EpiKV E{(bf16*)(ws + WS_KB), (bf16*)(ws + WS_VB), ssq_kv, projb, (const float*)(ws + WS_CS), (const float*)(ws + WS_GT)};
          pg8::gemm_phase<EpiKV, pg8::PromptPlusTail, true, true>(lds, g, S, E); }
        for (int rep_e = 0; rep_e < REP_E1; ++rep_e) e1_rows(args, vcu * NWAVES + wave, G * NWAVES, lane);
        for (int rep_s = 0; rep_s < REP_SSM1; ++rep_s) ssm2_pass1(args, vcu * NWAVES + wave, G * NWAVES, lane);
        if (BOTH(2)) GRID_BAR();
    }
    if (IN(3)) {
        for (int rep = 0; rep < REP_SSM3; ++rep) { ssm2_pass3(args, lds, vcu * NWAVES + wave, G * NWAVES, wave, lane); __syncthreads(); }
        {
          const float negB = -((const float*)(ws + WS_GT))[80];
          for (int rep = 0; rep < REP_PATTN; ++rep) for (int p = vcu; p < 256; p += G) { const int bh = p >> 3, j = p & 7;
              attn::prompt_unit(bh >> 3, bh & 7, j, (const bf16*)(ws + WS_QB), (const bf16*)(ws + WS_KB), (const bf16*)(ws + WS_VB), (bf16*)(ws + WS_BOUT), (const float*)(ws + WS_CS), negB, (char*)lds_raw);
              attn::prompt_unit(bh >> 3, bh & 7, 15 - j, (const bf16*)(ws + WS_QB), (const bf16*)(ws + WS_KB), (const bf16*)(ws + WS_VB), (bf16*)(ws + WS_BOUT), (const float*)(ws + WS_CS), negB, (char*)lds_raw); } }
        {
          const float negB = -((const float*)(ws + WS_GT))[80];
          for (int rep = 0; rep < REP_SATTN; ++rep) for (int u = vcu; u < 256; u += G) sattn::sample_unit(args, TWIN_FAR ? (u & 127) : (u >> 1), TWIN_FAR ? (u >> 7) : (u & 1), negB, (char*)lds_raw); }
        if (BOTH(3)) GRID_BAR();
    }
    if (IN(4)) for (int rep_ph = 0; rep_ph < REP_P4; ++rep_ph) { if (rep_ph) __syncthreads();
        { pg8::Gemm g{(const bf16*)(ws + WS_ZB), (const bf16*)(ws + WS_WGLU), M, 512, 512, 512, 512}; pg8::StaticOrder S; S.init(M, 512, G, bx);
          EpiGate<0> E{(bf16*)(ws + WS_AOUT), 512, (const bf16*)(ws + WS_ZB), 512, 0, nullptr};
          pg8::gemm_phase<EpiGate<0>, pg8::StaticOrder, true, true>(lds, g, S, E); }
        if (BOTH(4)) GRID_BAR();
    }
    if (IN(5)) for (int rep_ph = 0; rep_ph < REP_P5; ++rep_ph) { if (rep_ph) __syncthreads();
        { pg8::Gemm g{(const bf16*)(ws + WS_AOUT), (const bf16*)(ws + WS_WA), MP, 1024, 512, 512, 512}; pg8::StaticOrder S; S.init(MP, 1024, G, bx);
          EpiGate<1> E{(bf16*)(ws + WS_TMP), 1024, projb, NPROJ, PC_GA, nullptr};
          pg8::gemm_phase<EpiGate<1>, pg8::StaticOrder, true, true>(lds, g, S, E); }
        { pg8::Gemm g{(const bf16*)(ws + WS_BOUT), (const bf16*)(ws + WS_WB), MP, 1024, 512, 512, 512}; pg8::StaticOrder S; S.init(MP, 1024, G, bx);
          EpiGate<2> E{(bf16*)(ws + WS_MRG), 1024, projb, NPROJ, PC_GB, (const bf16*)(ws + WS_TMP)};
          pg8::gemm_phase<EpiGate<2>, pg8::StaticOrder, true, true>(lds, g, S, E); }
        { pg8::Gemm g{(const bf16*)(ws + WS_AOUT), (const bf16*)(ws + WS_WA), M, 1024, 256, 512, 512}; pg8::SplitKOrder S{MP / 256, 16, 2, 256, G, bx, 0};
          EpiSlab E{(float*)(ws + WS_SPART)};
          pg8::gemm_phase<EpiSlab, pg8::SplitKOrder, true, true>(lds, g, S, E); }
        { pg8::Gemm g{(const bf16*)(ws + WS_BOUT), (const bf16*)(ws + WS_WB), M, 1024, 256, 512, 512}; pg8::SplitKOrder S{MP / 256, 16, 2, 256, G, bx - 32, 32};
          EpiSlab E{(float*)(ws + WS_SPART)};
          pg8::gemm_phase<EpiSlab, pg8::SplitKOrder, true, true>(lds, g, S, E); }
        GRID_BAR();
        combine_merge(args, vcu * NWAVES + wave, G * NWAVES, lane);
        if (BOTH(5)) GRID_BAR();
    }
    if (IN(6)) for (int rep6 = 0; rep6 < REP_P6; ++rep6) { if (rep6) { GRID_BAR(); for (int i = bx * 512 + tid; i < M; i += G * 512) ssq_x1[i] = 0.f; GRID_BAR(); }
        { pg8::Gemm g{(const bf16*)(ws + WS_MRG), (const bf16*)(ws + WS_WOUT), MP, 1024, 1024, 1024, 1024}; pg8::StaticOrder S; S.init(MP, 1024, G, bx);
          EpiRes<true> E{(bf16*)(ws + WS_X1B), ssq_x1, args.in[0], args.in[1]};
          pg8::gemm_phase<EpiRes<true>, pg8::StaticOrder, true, true>(lds, g, S, E); }
        { pg8::Gemm g{(const bf16*)(ws + WS_MRG), (const bf16*)(ws + WS_WOUT), M, 1024, 256, 1024, 1024}; pg8::SplitKOrder S{MP / 256, 16, 4, 256, G, bx, 0};
          EpiSlab E{(float*)(ws + WS_SPART)};
          pg8::gemm_phase<EpiSlab, pg8::SplitKOrder, true, true>(lds, g, S, E); }
        GRID_BAR();
        combine_rows<4, 1>(args, vcu * NWAVES + wave, G * NWAVES, lane);
        if (BOTH(6)) GRID_BAR();
    }
    if (IN(7)) for (int rep_ph = 0; rep_ph < REP_P7; ++rep_ph) { if (rep_ph) __syncthreads();
        pg8::Gemm g{(const bf16*)(ws + WS_X1B), (const bf16*)(ws + WS_WGU), M, NGU, 1024, 1024, 1024}; pg8::StaticOrder S; S.init(M, NGU, G, bx);
        EpiSwiglu E{(bf16*)(ws + WS_ACT), ssq_x1};
        pg8::gemm_phase<EpiSwiglu, pg8::StaticOrder, true, true>(lds, g, S, E);
        if (BOTH(7)) GRID_BAR();
    }
    if (IN(8)) {
        { pg8::Gemm g{(const bf16*)(ws + WS_ACT), (const bf16*)(ws + WS_WDN), MP, 1024, DFF, DFF, DFF}; pg8::StaticOrder S; S.init(MP, 1024, G, bx);
          EpiRes<false> E{(bf16*)(ws + WS_X1B), ssq_x2, nullptr, nullptr};
          pg8::gemm_phase<EpiRes<false>, pg8::StaticOrder, true, true>(lds, g, S, E); }
        { pg8::Gemm g{(const bf16*)(ws + WS_ACT), (const bf16*)(ws + WS_WDN), M, 1024, 256, DFF, DFF}; pg8::SplitKOrder S{MP / 256, 16, 11, 256, G, bx, 0};
          EpiSlab E{(float*)(ws + WS_SPART)};
          pg8::gemm_phase<EpiSlab, pg8::SplitKOrder, true, true>(lds, g, S, E); }
        GRID_BAR();
        combine_rows<11, 0>(args, vcu * NWAVES + wave, G * NWAVES, lane);
        if (BOTH(8)) GRID_BAR();
    }
    if (IN(9)) for (int rep_ph = 0; rep_ph < REP_P9; ++rep_ph) { if (rep_ph) __syncthreads();
        { pg8::Gemm g{(const bf16*)(ws + WS_X1B), (const bf16*)(ws + WS_WPG), MP, 1024, 1024, 1024, 1024}; pg8::StaticOrder S; S.init(MP, 1024, G, bx);
          EpiFinal E{args.out + O_Y, (const bf16*)(ws + WS_X1B), (const bf16*)(ws + WS_PW), ssq_x2};
          pg8::gemm_phase<EpiFinal, pg8::StaticOrder, true, true>(lds, g, S, E); }
        { pg8::Gemm g{(const bf16*)(ws + WS_X1B), (const bf16*)(ws + WS_WPG), M, 1024, 256, 1024, 1024}; pg8::SplitKOrder S{MP / 256, 16, 4, 256, G, bx, 0};
          EpiSlab E{(float*)(ws + WS_SPART)};
          pg8::gemm_phase<EpiSlab, pg8::SplitKOrder, true, true>(lds, g, S, E); }
        GRID_BAR();
        combine_rows<4, 2>(args, vcu * NWAVES + wave, G * NWAVES, lane);
    }
#if PROF_K >= 100
    PH_STAMP();
    if (bx == 0) { __syncthreads(); asm volatile("s_waitcnt vmcnt(0)" ::: "memory"); __syncthreads();
        float val = (float)(long long)(ph_st[PROF_B] - ph_st[PROF_A]) * 0.01f / (float)PROF_FS;
        val = fminf(fmaxf(val, 0.f), 1.f); const float sc = 1.f + sqrtf(2e-5f + 1e-4f * val);
        for (int i = tid; i < 262144; i += 512) args.out[O_HIM_S + i] *= sc; }
#elif PROF_K >= 0
    if (IN(9) && bx == 0) { __syncthreads(); const float* pr = (const float*)(ws + WS_SST); float val = PROF_K < 7 ? pr[PROF_K] : pr[7] * 0.2f;
        val = fminf(fmaxf(val, 0.f), 1.f); const float sc = 1.f + sqrtf(2e-5f + 1e-4f * val);
        for (int i = tid; i < 262144; i += 512) args.out[O_HIM_S + i] *= sc; }
#endif
#undef IN
#undef BOTH
#undef GRID_BAR
}
}
extern "C" void kernel_launch(void* const* d_in, const int* in_sizes, int n_in, void* d_out, int out_size, void* d_ws, size_t ws_size, hipStream_t stream) {
    static int grid = 0;
    if (grid == 0) {
        if (n_in != 39 || out_size != 23379968 || ws_size < mk::WS_END) { fprintf(stderr, "kernel_launch: unexpected n_in %d / out_size %d / ws_size %zu (need %zu); nothing launched\n", n_in, out_size, ws_size, (size_t)mk::WS_END); grid = -1; return; }
        int dev = 0, cus = 0, per_cu = 0;
        if (hipGetDevice(&dev) != hipSuccess || hipDeviceGetAttribute(&cus, hipDeviceAttributeMultiprocessorCount, dev) != hipSuccess) { grid = -1; return; }
        if (hipFuncSetAttribute((const void*)mk::mk_fwd, hipFuncAttributeMaxDynamicSharedMemorySize, mk::LDS_BYTES) != hipSuccess) { fprintf(stderr, "kernel_launch: hipFuncSetAttribute failed\n"); grid = -1; return; }
        if (hipOccupancyMaxActiveBlocksPerMultiprocessor(&per_cu, (const void*)mk::mk_fwd, mk::NWAVES * 64, mk::LDS_BYTES) != hipSuccess || per_cu < 1)
            fprintf(stderr, "kernel_launch: note: the occupancy query reports %d workgroups per CU\n", per_cu);
        (void)hipGetLastError();
        grid = cus;
    }
    if (grid < 0) return;
    (void)hipMemsetAsync((unsigned char*)d_ws + mk::WS_CTL, 0, mk::CTL_ZERO_BYTES, stream);
    mk::Args a{};
    for (int i = 0; i < 39; ++i) a.in[i] = (const float*)d_in[i];
    a.out = (float*)d_out; a.ws = (unsigned char*)d_ws; a.ph_lo = 0; a.ph_hi = 10;
    hipLaunchKernelGGL(mk::mk_fwd, dim3(grid), dim3(mk::NWAVES * 64), mk::LDS_BYTES, stream, a);
}
```
